# Optimizing an MI355X kernel written in HIP

```python
import jax
import jax.numpy as jnp
from jax import lax
import numpy as np

D_MODEL = 2048
BATCH = 4
SEQ = 2048
DEPTH = 2
DEC_BATCH = 32
DEC_SEQ = 4
PAST_LEN = 8192
PAGE_SIZE = 128

N_BRANCH = 4
BRANCH_WIDTH = D_MODEL // N_BRANCH
ATT_WINDOWS = (128, 512, 2048)
ATT_DILATIONS = (1, 4, 16)
ATT_GROUPS = 3
ATT_HEADS_PER_GROUP = 4
ATT_HEADS = ATT_GROUPS * ATT_HEADS_PER_GROUP
ATT_HEAD_DIM = BRANCH_WIDTH // ATT_HEADS_PER_GROUP
ATT_WIDTH = ATT_HEADS * ATT_HEAD_DIM
ATT_Q_BLOCK = 128
REL_BUCKETS = 32
REL_MAX_DISTANCE = 2048
GMLP_WIDTH = BRANCH_WIDTH
GMLP_GROUPS = 4
GMLP_GROUP_WIDTH = GMLP_WIDTH // GMLP_GROUPS
GMLP_CHUNK = 128
POOL_WINDOWS = (2, 4, 8, 16)
POOL_WIDTH = BRANCH_WIDTH
POOL_GROUP_WIDTH = POOL_WIDTH // 4
POOL_STATE = 15
RET_HEADS = 4
RET_HEAD_DIM = BRANCH_WIDTH // RET_HEADS
RET_WIDTH = BRANCH_WIDTH
RET_CHUNK = 128
ROPE_BASE = 10000.0
D_FF = 5632
EPS = 1e-6
IN_SIZES = (ATT_WIDTH, ATT_WIDTH, ATT_WIDTH, GMLP_WIDTH, GMLP_WIDTH, POOL_WIDTH,
            RET_WIDTH, RET_WIDTH, RET_WIDTH, RET_WIDTH, N_BRANCH * D_MODEL)
IN_WIDTH = 16384

kernel_name = "hybrid_dilated_gmlp_pool_retention_decoder_step"


def rmsnorm(x, g):
    xf = x.astype(jnp.float32)
    y = xf * lax.rsqrt(jnp.mean(xf * xf, axis=-1, keepdims=True) + EPS)
    return (y * g.astype(jnp.float32)).astype(x.dtype)


def swiglu(x, w_gate, w_up, w_down):
    return (jax.nn.silu(x @ w_gate) * (x @ w_up)) @ w_down


def t5_causal_buckets(dist):
    max_exact = REL_BUCKETS // 2
    d = np.maximum(dist, 1).astype(np.float32)
    large = max_exact + (np.log(d / max_exact) / np.log(REL_MAX_DISTANCE / max_exact)
                         * (REL_BUCKETS - max_exact)).astype(np.int32)
    large = np.minimum(large, REL_BUCKETS - 1)
    return np.where(dist < max_exact, dist, large).astype(np.int32)


def dilated_group_attention(q, k_ext, v_ext, n_past, dil, bias):
    B, T, H, hd = q.shape
    nk = bias.shape[0]
    qb = T if T <= ATT_Q_BLOCK else ATT_Q_BLOCK
    nb = T // qb
    steps = dil * jnp.arange(nk)
    scale = hd ** -0.5
    bias_t = bias.astype(jnp.float32).T

    def block(bi):
        s0 = bi * qb
        q_blk = lax.dynamic_slice_in_dim(q, s0, qb, axis=1)
        idx = n_past + s0 + jnp.arange(qb)[:, None] - steps[None, :]
        valid = idx >= 0
        idx = jnp.maximum(idx, 0)
        k_g = k_ext[:, idx]
        v_g = v_ext[:, idx]
        s = jnp.einsum('bqhd,bqnhd->bqhn', q_blk, k_g).astype(jnp.float32) * scale + bias_t
        s = jnp.where(valid[None, :, None, :], s, -jnp.inf)
        m = jnp.max(s, axis=-1, keepdims=True)
        p = jnp.exp(s - m)
        den = jnp.sum(p, axis=-1)
        o = jnp.einsum('bqhn,bqnhd->bqhd', p, v_g.astype(jnp.float32)) / den[..., None]
        return o, m[..., 0] + jnp.log(den)

    o, lse = lax.map(block, jnp.arange(nb))
    o = jnp.moveaxis(o, 0, 1).reshape(B, T, H, hd)
    lse = jnp.moveaxis(lse, 0, 1).reshape(B, T, H)
    return o, lse


def pool_mixer(xc, buf, start, w_pool, pool_scale):
    B, T, C = xc.shape
    L = buf.shape[1]
    ext = jnp.concatenate([buf.astype(xc.dtype), xc], axis=1)
    csum = jnp.cumsum(ext.astype(jnp.float32), axis=1)
    csum = jnp.concatenate([jnp.zeros((B, 1, C), jnp.float32), csum], axis=1)
    end = L + 1 + jnp.arange(T)
    pos = start + jnp.arange(T)
    pooled = []
    for gi, win in enumerate(POOL_WINDOWS):
        sl = slice(gi * POOL_GROUP_WIDTH, (gi + 1) * POOL_GROUP_WIDTH)
        wsum = csum[:, end, sl] - csum[:, end - win, sl]
        cnt = jnp.minimum(pos + 1, win).astype(jnp.float32)
        pooled.append(wsum / cnt[None, :, None])
    diff = jnp.concatenate(pooled, axis=-1) - xc.astype(jnp.float32)
    diff = diff.reshape(B, T, len(POOL_WINDOWS), POOL_GROUP_WIDTH)
    y = jnp.einsum('btgc,gcd->btgd', diff, w_pool.astype(jnp.float32)).reshape(B, T, C)
    y = y * pool_scale.astype(jnp.float32)
    return y.astype(xc.dtype), ext[:, ext.shape[1] - L:]


def rotate(x, pos):
    d = x.shape[-1]
    half = d // 2
    inv = ROPE_BASE ** (-jnp.arange(half, dtype=jnp.float32) / half)
    ang = pos.astype(jnp.float32)[:, None] * inv[None, :]
    cos = jnp.cos(ang)[None, :, None, :]
    sin = jnp.sin(ang)[None, :, None, :]
    x1 = x[..., :half].astype(jnp.float32)
    x2 = x[..., half:].astype(jnp.float32)
    return jnp.concatenate([x1 * cos - x2 * sin, x1 * sin + x2 * cos], axis=-1)


def retention(q, k, v, s0):
    B, T, H, d = q.shape
    c = RET_CHUNK if T % RET_CHUNK == 0 else T
    n = T // c
    lg = jnp.log1p(-jnp.power(2.0, -5.0 - jnp.arange(H, dtype=jnp.float32)))
    i = jnp.arange(c, dtype=jnp.float32)
    diff = i[:, None] - i[None, :]
    inner_decay = jnp.where(diff >= 0, jnp.exp(jnp.maximum(diff, 0.0)[None] * lg[:, None, None]), 0.0)
    q_decay = jnp.exp((i + 1.0)[None, :] * lg[:, None])
    k_decay = jnp.exp((c - 1.0 - i)[None, :] * lg[:, None])
    chunk_decay = jnp.exp(c * lg)

    def to_chunks(a):
        return a.astype(jnp.float32).reshape(B, n, c, H, d).transpose(1, 0, 3, 2, 4)

    def step(S, inp):
        qi, ki, vi = inp
        att = jnp.einsum('bhtd,bhsd->bhts', qi, ki) * inner_decay
        o = (jnp.einsum('bhts,bhsd->bhtd', att, vi)
             + jnp.einsum('bhtd,bhde->bhte', qi, S) * q_decay[None, :, :, None])
        S = (S * chunk_decay[None, :, None, None]
             + jnp.einsum('bhsd,bhse->bhde', ki * k_decay[None, :, :, None], vi))
        return S, o

    S, o = lax.scan(step, s0.astype(jnp.float32), (to_chunks(q), to_chunks(k), to_chunks(v)))
    o = o.transpose(1, 0, 3, 2, 4).reshape(B, T, H, d)
    return o, S


def decoder_layer(x, start, kv_bufs, pool_buf, ret_state, rel_bias,
                  g_ffn1, w_ffn1_gate, w_ffn1_up, w_ffn1_down,
                  g_mix, w_in, g_gmlp, w_spatial, b_spatial, w_pool, pool_scale, g_ret,
                  w_branch, w_out, g_ffn2, w_ffn2_gate, w_ffn2_up, w_ffn2_down):
    B, T, _ = x.shape
    f32 = jnp.float32
    x = x + 0.5 * swiglu(rmsnorm(x, g_ffn1), w_ffn1_gate, w_ffn1_up, w_ffn1_down)
    h = rmsnorm(x, g_mix)
    z = h @ w_in
    splits = [int(s) for s in np.cumsum(IN_SIZES)[:-1]]
    a_q, a_k, a_v, b_u, b_v, c_in, d_q, d_k, d_v, d_g, z_gate = jnp.split(z, splits, axis=-1)

    hg, hd = ATT_HEADS_PER_GROUP, ATT_HEAD_DIM
    shp = (B, T, ATT_GROUPS, hg, hd)
    a_q, a_k, a_v = a_q.reshape(shp), a_k.reshape(shp), a_v.reshape(shp)
    outs, lses, kv_new = [], [], []
    for gi in range(ATT_GROUPS):
        win, dil = ATT_WINDOWS[gi], ATT_DILATIONS[gi]
        kv_g = jnp.stack([a_k[:, :, gi], a_v[:, :, gi]], axis=2)
        kv_new.append(kv_g)
        kv_ext = jnp.concatenate([kv_bufs[gi].astype(kv_g.dtype), kv_g], axis=1)
        n_key = win // dil + 1
        bucket = t5_causal_buckets(dil * np.arange(n_key))
        bias = rel_bias[bucket][:, gi * hg:(gi + 1) * hg]
        o, lse = dilated_group_attention(a_q[:, :, gi], kv_ext[:, :, 0], kv_ext[:, :, 1],
                                         kv_bufs[gi].shape[1], dil, bias)
        outs.append(o)
        lses.append(lse)
    w_den = jax.nn.softmax(jnp.stack(lses), axis=0)
    o_a = jnp.sum(w_den[..., None] * jnp.stack(outs), axis=0).reshape(B, T, BRANCH_WIDTH).astype(x.dtype)

    u = jax.nn.gelu(b_u)
    vn = rmsnorm(jax.nn.gelu(b_v), g_gmlp)
    c = T if T < GMLP_CHUNK else GMLP_CHUNK
    vc = vn.reshape(B, T // c, c, GMLP_GROUPS, GMLP_GROUP_WIDTH)
    ws = w_spatial[:, :c, :c] * jnp.tril(jnp.ones((c, c), w_spatial.dtype))
    mixed = jnp.einsum('gts,bnsgc->bntgc', ws, vc) + b_spatial[:, :c].T[None, None, :, :, None]
    o_b = u * mixed.reshape(B, T, GMLP_WIDTH)

    o_c, pool_new = pool_mixer(c_in, pool_buf, start, w_pool, pool_scale)

    hs = (B, T, RET_HEADS, RET_HEAD_DIM)
    pos = start + jnp.arange(T)
    rq = rotate(d_q.reshape(hs), pos)
    rk = rotate(d_k.reshape(hs), pos) * (RET_HEAD_DIM ** -0.5)
    o_d, ret_new = retention(rq, rk, d_v.reshape(hs), ret_state)
    o_d = o_d * lax.rsqrt(jnp.mean(o_d * o_d, axis=-1, keepdims=True) + EPS)
    o_d = (o_d.reshape(B, T, RET_WIDTH) * g_ret.astype(f32) * jax.nn.silu(d_g.astype(f32))).astype(x.dtype)

    br = jnp.stack([o_a, o_b.astype(x.dtype), o_c, o_d], axis=2)
    proj = jnp.einsum('btnc,ncd->btnd', br, w_branch)
    gate = jax.nn.sigmoid(z_gate.reshape(B, T, N_BRANCH, D_MODEL))
    x = x + jnp.sum(gate * proj, axis=2) @ w_out
    x = x + 0.5 * swiglu(rmsnorm(x, g_ffn2), w_ffn2_gate, w_ffn2_up, w_ffn2_down)
    return x, kv_new, pool_new, ret_new, vn


def setup_inputs(seed: int = 0) -> dict:
    key = jax.random.key(seed)
    keys = jax.random.split(key, 32)
    f32 = jnp.float32
    hg, hd = ATT_HEADS_PER_GROUP, ATT_HEAD_DIM

    def nrm(i, shape, scale):
        return jax.random.normal(keys[i], shape, f32) * scale

    def gain(i, shape):
        return 1.0 + 0.05 * jax.random.normal(keys[i], shape, f32)

    return {
        "x_prompt": nrm(0, (BATCH, SEQ, D_MODEL), 1.0),
        "x_sample": nrm(1, (DEC_BATCH, DEC_SEQ, D_MODEL), 1.0),
        "cache_attn_kv_w128": nrm(2, (DEPTH, DEC_BATCH, min(ATT_WINDOWS[0], PAST_LEN), 2, hg, hd), 1.0),
        "cache_attn_kv_w512": nrm(3, (DEPTH, DEC_BATCH, min(ATT_WINDOWS[1], PAST_LEN), 2, hg, hd), 1.0),
        "cache_attn_kv_w2048": nrm(4, (DEPTH, DEC_BATCH, min(ATT_WINDOWS[2], PAST_LEN), 2, hg, hd), 1.0),
        "state_pool": nrm(5, (DEPTH, DEC_BATCH, POOL_STATE, POOL_WIDTH), 1.0),
        "state_ret": nrm(6, (DEPTH, DEC_BATCH, RET_HEADS, RET_HEAD_DIM, RET_HEAD_DIM), 0.3),
        "rel_bias": nrm(7, (REL_BUCKETS, ATT_HEADS), 0.5),
        "g_ffn1": gain(8, (DEPTH, D_MODEL)),
        "w_ffn1_gate": nrm(9, (DEPTH, D_MODEL, D_FF), D_MODEL ** -0.5),
        "w_ffn1_up": nrm(10, (DEPTH, D_MODEL, D_FF), D_MODEL ** -0.5),
        "w_ffn1_down": nrm(11, (DEPTH, D_FF, D_MODEL), D_FF ** -0.5),
        "g_mix": gain(12, (DEPTH, D_MODEL)),
        "w_in": nrm(13, (DEPTH, D_MODEL, IN_WIDTH), D_MODEL ** -0.5),
        "g_gmlp": gain(14, (DEPTH, GMLP_WIDTH)),
        "w_spatial": nrm(15, (DEPTH, GMLP_GROUPS, GMLP_CHUNK, GMLP_CHUNK), GMLP_CHUNK ** -0.5),
        "b_spatial": 1.0 + nrm(16, (DEPTH, GMLP_GROUPS, GMLP_CHUNK), 0.02),
        "w_pool": nrm(17, (DEPTH, len(POOL_WINDOWS), POOL_GROUP_WIDTH, POOL_GROUP_WIDTH), POOL_GROUP_WIDTH ** -0.5),
        "pool_scale": gain(18, (DEPTH, POOL_WIDTH)),
        "g_ret": gain(19, (DEPTH, RET_WIDTH)),
        "w_branch": nrm(20, (DEPTH, N_BRANCH, BRANCH_WIDTH, D_MODEL), BRANCH_WIDTH ** -0.5),
        "w_out": nrm(21, (DEPTH, D_MODEL, D_MODEL), D_MODEL ** -0.5),
        "g_ffn2": gain(22, (DEPTH, D_MODEL)),
        "w_ffn2_gate": nrm(23, (DEPTH, D_MODEL, D_FF), D_MODEL ** -0.5),
        "w_ffn2_up": nrm(24, (DEPTH, D_MODEL, D_FF), D_MODEL ** -0.5),
        "w_ffn2_down": nrm(25, (DEPTH, D_FF, D_MODEL), D_FF ** -0.5),
        "g_final": gain(26, (D_MODEL,)),
    }


def reference(x_prompt, x_sample, cache_attn_kv_w128, cache_attn_kv_w512, cache_attn_kv_w2048,
              state_pool, state_ret, rel_bias,
              g_ffn1, w_ffn1_gate, w_ffn1_up, w_ffn1_down,
              g_mix, w_in, g_gmlp, w_spatial, b_spatial, w_pool, pool_scale, g_ret,
              w_branch, w_out, g_ffn2, w_ffn2_gate, w_ffn2_up, w_ffn2_down, g_final):
    caches = (cache_attn_kv_w128, cache_attn_kv_w512, cache_attn_kv_w2048)
    bp, tp = x_prompt.shape[0], x_prompt.shape[1]
    hp, hs = x_prompt, x_sample
    kv_p = [[], [], []]
    kv_s = [[], [], []]
    pool_p, pool_s, ret_p, ret_s, gv_s = [], [], [], [], []
    for l in range(DEPTH):
        lw = (rel_bias, g_ffn1[l], w_ffn1_gate[l], w_ffn1_up[l], w_ffn1_down[l],
              g_mix[l], w_in[l], g_gmlp[l], w_spatial[l], b_spatial[l], w_pool[l], pool_scale[l], g_ret[l],
              w_branch[l], w_out[l], g_ffn2[l], w_ffn2_gate[l], w_ffn2_up[l], w_ffn2_down[l])
        empty_kv = tuple(jnp.zeros((bp, 0, 2, ATT_HEADS_PER_GROUP, ATT_HEAD_DIM), hp.dtype)
                         for _ in ATT_WINDOWS)
        hp, kvn, pooln, retn, _ = decoder_layer(
            hp, 0, empty_kv, jnp.zeros((bp, POOL_STATE, POOL_WIDTH), hp.dtype),
            jnp.zeros((bp, RET_HEADS, RET_HEAD_DIM, RET_HEAD_DIM), jnp.float32), *lw)
        for gi in range(ATT_GROUPS):
            keep = min(ATT_WINDOWS[gi], tp)
            kv_p[gi].append(kvn[gi][:, tp - keep:])
        pool_p.append(pooln)
        ret_p.append(retn)
        hs, kvn, pooln, retn, gvn = decoder_layer(
            hs, PAST_LEN, tuple(cc[l] for cc in caches), state_pool[l], state_ret[l], *lw)
        for gi in range(ATT_GROUPS):
            kv_s[gi].append(kvn[gi])
        pool_s.append(pooln)
        ret_s.append(retn)
        gv_s.append(gvn)
    y_prompt = rmsnorm(hp, g_final)
    y_sample = rmsnorm(hs, g_final)
    return (y_prompt, y_sample,
            jnp.stack(kv_p[0]), jnp.stack(kv_p[1]), jnp.stack(kv_p[2]),
            jnp.stack(kv_s[0]), jnp.stack(kv_s[1]), jnp.stack(kv_s[2]),
            jnp.stack(pool_p), jnp.stack(pool_s),
            jnp.stack(ret_p), jnp.stack(ret_s),
            jnp.stack(gv_s))
```

```cpp
#include <hip/hip_runtime.h>
#include <cstdio>
#include <cstdint>
#ifndef ONE_LAUNCH
#define ONE_LAUNCH 1
#endif
#ifndef PH_MASK
#define PH_MASK 0x1ff
#endif
#ifndef GP_ALIGN
#define GP_ALIGN true
#endif
#ifndef GP_SP2
#define GP_SP2 true
#endif
namespace pg8 {
#define PG8_LAS __attribute__((address_space(3)))
typedef unsigned short bf16_t;
typedef short bf16x8 __attribute__((ext_vector_type(8)));
typedef float f32x4 __attribute__((ext_vector_type(4)));
typedef unsigned u32x4 __attribute__((ext_vector_type(4)));
constexpr int BM = 256, BK = 64, HALF = 128, HTB = HALF * BK * 2  , STAGE_BYTES = 8 * HTB, NXCD = 8, WGM = 8;

__host__ __device__ __forceinline__ int lds_byte(int r, int c) { const int st = (r >> 4) * 2 + (c >> 5), rr = r & 15, cc = c & 31, ob = rr * 64 + cc * 2; return st * 1024 + (ob ^ (((ob >> 9) & 1) << 5)); }
__host__ __device__ __forceinline__ void stage_rc(int b, int& R, int& C) { const int st = b / 1024, sb = b % 1024, swz = sb ^ (((sb >> 9) & 1) << 5); R = (st >> 1) * 16 + swz / 64; C = (st & 1) * 32 + (swz % 64) / 2; }
__host__ __device__ __forceinline__ int perm32(int rho) { const int n = rho >> 4, i = rho & 15; return 8 * (i >> 2) + 4 * n + (i & 3); }

struct Unit { int pm, pn; };
struct Gemm { const bf16_t* A; const bf16_t* Bt; int M, N, K; };

struct StaticOrder {
    int nM, nN, nwg, G, c;
    __host__ __device__ void init(int M, int N, int G_, int c_) { nM = M / BM; nN = N / BM; nwg = nM * nN; G = G_; c = c_; }
    __host__ __device__ bool next(int i, Unit& u) const {
        const long L = (long)i * G + c; if (L >= nwg) return false;
        int wgid = (int)L; { const int q = nwg / NXCD, r = nwg % NXCD, xcd = wgid % NXCD, off = wgid / NXCD; wgid = (xcd < r ? xcd * (q + 1) : r * (q + 1) + (xcd - r) * q) + off; }
        const int nig = WGM * nN, gid = wgid / nig, fm = gid * WGM, gsz = (nM - fm) < WGM ? (nM - fm) : WGM;
        u.pm = fm + ((wgid % nig) % gsz); u.pn = (wgid % nig) / gsz; return true;
    }
    __device__ __forceinline__ void a_ready(const Unit&) const {}
    __device__ __forceinline__ void done(const Unit&) const {}
};
__device__ __forceinline__ unsigned cvt_pk_bf16(float lo, float hi) { unsigned r; asm volatile("v_cvt_pk_bf16_f32 %0, %1, %2" : "=v"(r) : "v"(lo), "v"(hi)); return r; }
typedef float f32x2 __attribute__((ext_vector_type(2)));
typedef int i32x4 __attribute__((ext_vector_type(4)));
typedef int i32x8 __attribute__((ext_vector_type(8)));
__device__ __forceinline__ f32x4 mma8(bf16x8 b0, bf16x8 b1, bf16x8 a0, bf16x8 a1, f32x4 c) {
    const i32x8 B = __builtin_shufflevector(__builtin_bit_cast(i32x4, b0), __builtin_bit_cast(i32x4, b1), 0, 1, 2, 3, 4, 5, 6, 7);
    const i32x8 A = __builtin_shufflevector(__builtin_bit_cast(i32x4, a0), __builtin_bit_cast(i32x4, a1), 0, 1, 2, 3, 4, 5, 6, 7);
    return __builtin_amdgcn_mfma_scale_f32_16x16x128_f8f6f4(B, A, c, 0, 0, 0, 0x7f7f7f7f, 0, 0x7f7f7f7f);
}
template <class Epi, class Sched, bool ALIGN_EPI = false, bool SP2 = false, bool F8 = false, int HALFPM = -1>
__device__ __forceinline__ void gemm_phase(PG8_LAS unsigned char* lds, const Gemm g, const Sched& S, const Epi& E) {
    const int tid = threadIdx.x, wid = __builtin_amdgcn_readfirstlane(tid >> 6), lane = tid & 63, wr = wid >> 2, wc = wid & 3, fr = lane & 15, fq = lane >> 4;
    const int K = g.K, nt = K / BK;
    unsigned voffA[2], voffB[2];
#pragma unroll
    for (int i = 0; i < 2; ++i) { int R, C; stage_rc(tid * 16 + i * 8192, R, C); const int Rb = Epi::PERM ? ((R & ~31) + perm32(R & 31)) : R;
        voffA[i] = (unsigned)(R * K + C) * 2u; voffB[i] = (unsigned)(Rb * K + C) * 2u; }
    const size_t kstep = (size_t)(BK * 2);
    const size_t hstep = (size_t)HALF * K * 2;
    const size_t tstep = 2 * hstep;
    const unsigned ldsw = (unsigned)wid * 1024u;
    const int aoff = lds_byte(wr * 64 + fr, fq * 8), boff = lds_byte(wc * 32 + fr, fq * 8);
#define PG8_SA(b, h) (((b) * 2 + (h)) * HTB)
#define PG8_SB(b, h) ((4 + (b) * 2 + (h)) * HTB)
#define PG8_STAGE(bufoff, gbase, voff) do { _Pragma("unroll") for (int _i = 0; _i < 2; ++_i) \
        __builtin_amdgcn_global_load_lds((const unsigned*)((const char*)(gbase) + (voff)[_i]), (PG8_LAS unsigned*)(lds + (bufoff) + ldsw + _i * 8192), 16, 0, 0); } while (0)
#define PG8_LD8(p) __builtin_shufflevector(*(const PG8_LAS i32x4*)(p), *(const PG8_LAS i32x4*)((p) + 1024), 0, 1, 2, 3, 4, 5, 6, 7)
#define PG8_LDA(dst, b, h) do { if constexpr (F8) { _Pragma("unroll") for (int m = 0; m < 4; ++m) dst##8[m] = PG8_LD8(lds + PG8_SA(b, h) + aoff + m * 2048); } \
        else { _Pragma("unroll") for (int m = 0; m < 4; ++m) _Pragma("unroll") for (int k = 0; k < 2; ++k) dst[m][k] = *(const PG8_LAS bf16x8*)(lds + PG8_SA(b, h) + aoff + m * 2048 + k * 1024); } } while (0)
#define PG8_LDB(dst, b, h) do { if constexpr (F8) { _Pragma("unroll") for (int n = 0; n < 2; ++n) dst##8[n] = PG8_LD8(lds + PG8_SB(b, h) + boff + n * 2048); } \
        else { _Pragma("unroll") for (int n = 0; n < 2; ++n) _Pragma("unroll") for (int k = 0; k < 2; ++k) dst[n][k] = *(const PG8_LAS bf16x8*)(lds + PG8_SB(b, h) + boff + n * 2048 + k * 1024); } } while (0)
#define PG8_MMA(ai, bj, At, Bt) do { __builtin_amdgcn_s_setprio(1); \
        if constexpr (F8) { _Pragma("unroll") for (int m = 0; m < 4; ++m) _Pragma("unroll") for (int n = 0; n < 2; ++n) asm volatile("v_mfma_scale_f32_16x16x128_f8f6f4 %0, %1, %2, %0, %3, %3 op_sel_hi:[0,0,0]" : "+v"(acc[ai][bj][m][n]) : "v"(Bt##8[n]), "v"(At##8[m]), "v"(0x7f7f7f7f)); } \
        else { _Pragma("unroll") for (int m = 0; m < 4; ++m) _Pragma("unroll") for (int n = 0; n < 2; ++n) _Pragma("unroll") for (int k = 0; k < 2; ++k) \
        acc[ai][bj][m][n] = __builtin_amdgcn_mfma_f32_16x16x32_bf16(Bt[n][k], At[m][k], acc[ai][bj][m][n], 0, 0, 0); } __builtin_amdgcn_s_setprio(0); } while (0)
#define PG8_WAIT_V(n) asm volatile("s_waitcnt vmcnt(" #n ")" ::: "memory")
#define PG8_WAIT_L(n) asm volatile("s_waitcnt lgkmcnt(" #n ")" ::: "memory")
#define PG8_BAR __builtin_amdgcn_s_barrier()
#define PG8_SCHED __builtin_amdgcn_sched_barrier(0)
    Unit cur, nxt; int ui = 0;
    if (!S.next(0, cur)) return;
    f32x4 acc[2][2][4][2];
#pragma unroll
    for (int a = 0; a < 2; ++a)
#pragma unroll
        for (int b = 0; b < 2; ++b)
#pragma unroll
            for (int m = 0; m < 4; ++m)
#pragma unroll
                for (int n = 0; n < 2; ++n) acc[a][b][m][n] = (f32x4){0.f, 0.f, 0.f, 0.f};
    bf16x8 At[4][2], B0[2][2], B1[2][2]; i32x8 At8[4], B08[2], B18[2];
    const char* cA = (const char*)g.A + (size_t)cur.pm * tstep; const char* cB = (const char*)g.Bt + (size_t)cur.pn * tstep;
    S.a_ready(cur);
    if constexpr (SP2) {
        PG8_STAGE(PG8_SB(0, 0), cB, voffB); PG8_STAGE(PG8_SB(0, 1), cB + hstep, voffB); PG8_STAGE(PG8_SA(0, 0), cA, voffA); PG8_STAGE(PG8_SA(0, 1), cA + hstep, voffA);
        if (wr == 1) PG8_BAR;
        PG8_WAIT_V(2); PG8_BAR;
        PG8_STAGE(PG8_SB(1, 0), cB + kstep, voffB); PG8_STAGE(PG8_SA(1, 0), cA + kstep, voffA); PG8_STAGE(PG8_SB(1, 1), cB + hstep + kstep, voffB);
        PG8_WAIT_V(6); PG8_BAR;
    } else {
        PG8_STAGE(PG8_SB(0, 0), cB, voffB); PG8_STAGE(PG8_SA(0, 0), cA, voffA); PG8_STAGE(PG8_SB(0, 1), cB + hstep, voffB); PG8_STAGE(PG8_SA(0, 1), cA + hstep, voffA);
        if (wr == 1) PG8_BAR;
        PG8_WAIT_V(4); PG8_BAR;
        PG8_STAGE(PG8_SB(1, 0), cB + kstep, voffB); PG8_STAGE(PG8_SA(1, 0), cA + kstep, voffA); PG8_STAGE(PG8_SB(1, 1), cB + hstep + kstep, voffB);
        PG8_WAIT_V(6); PG8_BAR;
    }
    for (;;) {
        const bool has_next = S.next(ui + 1, nxt);
        const char* nA = has_next ? (const char*)g.A + (size_t)nxt.pm * tstep : cA; const char* nB = has_next ? (const char*)g.Bt + (size_t)nxt.pn * tstep : cB;
        for (int t = 0; t < nt; t += 2) {
            const bool last = (t == nt - 2);
            const char* a1 = cA + (size_t)(t + 1) * kstep;
            const char* a2 = last ? nA : cA + (size_t)(t + 2) * kstep; const char* b2 = last ? nB : cB + (size_t)(t + 2) * kstep;
            const char* a3 = a2 + kstep; const char* b3 = b2 + kstep;
            if (last && has_next) S.a_ready(nxt);
            if constexpr (SP2) {
            PG8_LDB(B0, 0, 0); PG8_LDB(B1, 0, 1); PG8_SCHED; PG8_LDA(At, 0, 0); PG8_STAGE(PG8_SA(1, 1), a1 + hstep, voffA);
            PG8_WAIT_V(8); PG8_WAIT_L(0); PG8_BAR; PG8_MMA(0, 0, At, B0); PG8_MMA(0, 1, At, B1); PG8_BAR; PG8_SCHED;
            if (HALFPM < 0 || cur.pm != HALFPM) PG8_LDA(At, 0, 1); PG8_STAGE(PG8_SB(0, 0), b2, voffB); PG8_STAGE(PG8_SB(0, 1), b2 + hstep, voffB); PG8_STAGE(PG8_SA(0, 0), a2, voffA);
            PG8_WAIT_V(8); PG8_WAIT_L(0); PG8_BAR; if (HALFPM < 0 || cur.pm != HALFPM) { PG8_MMA(1, 0, At, B0); PG8_MMA(1, 1, At, B1); } PG8_BAR; PG8_SCHED;
            PG8_LDB(B0, 1, 0); PG8_LDB(B1, 1, 1); PG8_SCHED; PG8_LDA(At, 1, 0); PG8_STAGE(PG8_SA(0, 1), a2 + hstep, voffA);
            PG8_WAIT_V(8); PG8_WAIT_L(0); PG8_BAR; PG8_MMA(0, 0, At, B0); PG8_MMA(0, 1, At, B1); PG8_BAR; PG8_SCHED;
            if (HALFPM < 0 || cur.pm != HALFPM) PG8_LDA(At, 1, 1); PG8_STAGE(PG8_SB(1, 0), b3, voffB); PG8_STAGE(PG8_SB(1, 1), b3 + hstep, voffB); PG8_STAGE(PG8_SA(1, 0), a3, voffA);
            PG8_WAIT_V(8); PG8_WAIT_L(0); PG8_BAR; if (HALFPM < 0 || cur.pm != HALFPM) { PG8_MMA(1, 0, At, B0); PG8_MMA(1, 1, At, B1); } PG8_BAR; PG8_SCHED;
            } else {
            PG8_LDB(B0, 0, 0); PG8_SCHED; PG8_LDA(At, 0, 0); PG8_STAGE(PG8_SA(1, 1), a1 + hstep, voffA);
            PG8_WAIT_L(8); PG8_BAR; PG8_WAIT_L(0); PG8_MMA(0, 0, At, B0); PG8_BAR; PG8_SCHED;
            PG8_LDB(B1, 0, 1); PG8_STAGE(PG8_SB(0, 0), b2, voffB);
            PG8_BAR; PG8_WAIT_L(0); PG8_MMA(0, 1, At, B1); PG8_BAR;
            PG8_LDA(At, 0, 1); PG8_STAGE(PG8_SA(0, 0), a2, voffA);
            PG8_BAR; PG8_WAIT_L(0); PG8_MMA(1, 0, At, B0); PG8_BAR; PG8_SCHED;
            PG8_STAGE(PG8_SB(0, 1), b2 + hstep, voffB);
            PG8_WAIT_V(6); PG8_BAR; PG8_MMA(1, 1, At, B1); PG8_BAR;
            PG8_LDB(B0, 1, 0); PG8_SCHED; PG8_LDA(At, 1, 0); PG8_STAGE(PG8_SA(0, 1), a2 + hstep, voffA);
            PG8_WAIT_L(8); PG8_BAR; PG8_WAIT_L(0); PG8_MMA(0, 0, At, B0); PG8_BAR; PG8_SCHED;
            PG8_LDB(B1, 1, 1); PG8_STAGE(PG8_SB(1, 0), b3, voffB);
            PG8_BAR; PG8_WAIT_L(0); PG8_MMA(0, 1, At, B1); PG8_BAR;
            PG8_LDA(At, 1, 1); PG8_STAGE(PG8_SA(1, 0), a3, voffA);
            PG8_BAR; PG8_WAIT_L(0); PG8_MMA(1, 0, At, B0); PG8_BAR; PG8_SCHED;
            PG8_STAGE(PG8_SB(1, 1), b3 + hstep, voffB);
            PG8_WAIT_V(6); PG8_BAR; PG8_MMA(1, 1, At, B1); PG8_BAR;
            }
        }
        if constexpr (ALIGN_EPI) { if (wr == 0) PG8_BAR; }
        if constexpr (F8) asm volatile("s_nop 15\n\ts_nop 15\n\ts_nop 15\n\ts_nop 15" ::: "memory");
        if constexpr (!Epi::AFTER_DRAIN) { E(acc, cur, wr, wc, fr, fq); S.done(cur); }
        if (!has_next) break;
        if constexpr (!Epi::CARRY) {
#pragma unroll
        for (int a = 0; a < 2; ++a)
#pragma unroll
            for (int b = 0; b < 2; ++b)
#pragma unroll
                for (int m = 0; m < 4; ++m)
#pragma unroll
                    for (int n = 0; n < 2; ++n) acc[a][b][m][n] = (f32x4){0.f, 0.f, 0.f, 0.f};
        }
        cur = nxt; cA = nA; cB = nB; ++ui;
        if constexpr (ALIGN_EPI) { if (wr == 1) PG8_BAR; }
    }
    PG8_WAIT_V(0);
    if constexpr (!ALIGN_EPI) { if (wr == 0) PG8_BAR; }
    PG8_BAR;
    if constexpr (Epi::AFTER_DRAIN) { E.fused(acc, cur, wr, wc, fr, fq, lds, wid, lane); S.done(cur); }
#undef PG8_SA
#undef PG8_SB
#undef PG8_STAGE
#undef PG8_LDA
#undef PG8_LD8
#undef PG8_LDB
#undef PG8_MMA
#undef PG8_WAIT_V
#undef PG8_WAIT_L
#undef PG8_BAR
#undef PG8_SCHED
}
}
#define LAS __attribute__((address_space(3)))
#define XB_TMO      128
#define XB_XCNT(j)  (256  + 64 * (j))
#define XB_XSUB(j)  (1280 + 64 * (j))
#define XB_XGEN(j)  (2304 + 64 * (j))
#define XB_TOP      3328
#define XB_TOPGEN   3392
#define XCD_BAR_WORDS 3456
#define XB_SPIN_CAP (1u << 18)

__device__ __forceinline__ unsigned xb_ld(unsigned* p)              { return __hip_atomic_load(p, __ATOMIC_RELAXED, __HIP_MEMORY_SCOPE_AGENT); }
typedef unsigned long long u64;
constexpr float SS_FIX = 4294967296.0f, SS_INV = 1.0f / 4294967296.0f;
__device__ __forceinline__ u64 ss_fix(float s) { return (u64)(s * SS_FIX); }
__device__ __forceinline__ void ss_add(u64* p, float s) { __hip_atomic_fetch_add(p, ss_fix(s), __ATOMIC_RELAXED, __HIP_MEMORY_SCOPE_AGENT); }
__device__ __forceinline__ float ss_get(const u64* p) { return (float)(*p) * SS_INV; }
__device__ __forceinline__ unsigned xb_add(unsigned* p, unsigned v) { return __hip_atomic_fetch_add(p, v, __ATOMIC_RELAXED, __HIP_MEMORY_SCOPE_AGENT); }
__device__ __forceinline__ unsigned xb_xcc_id() { return (unsigned)__builtin_amdgcn_s_getreg((3 << 11) | 20) & 0xFu; }
#define XB_SPIN(cond, bar) do { unsigned _sp = 0; while (cond) { __builtin_amdgcn_s_sleep(1); \
    if ((++_sp & 255u) == 0u) { if (xb_ld(&(bar)[XB_TMO])) break; if (_sp > XB_SPIN_CAP) { atomicAdd(&(bar)[XB_TMO], 1u); break; } } } } while (0)

struct XcdBarrier {
    unsigned* bar; unsigned x;
    volatile LAS unsigned* st;
};

__device__ __forceinline__ XcdBarrier xcd_barrier_post(unsigned* bar, volatile LAS unsigned* st) {
    XcdBarrier b; b.bar = bar; b.x = xb_xcc_id(); b.st = st;
    if (threadIdx.x == 0) (void)xb_add(&bar[XB_XCNT(b.x)], 1u);
    return b;
}
__device__ __forceinline__ void xcd_barrier_complete(unsigned* bar, unsigned x, unsigned& nloc, unsigned& nx) {
    const unsigned G = gridDim.x * gridDim.y * gridDim.z;
    unsigned sum, cnt, mine, sp = 0u;
    for (;;) {
        sum = 0u; cnt = 0u; mine = 0u;
#pragma unroll
        for (unsigned j = 0; j < 16; ++j) { const unsigned c = xb_ld(&bar[XB_XCNT(j)]); sum += c; cnt += (c > 0u) ? 1u : 0u; mine = (j == x) ? c : mine; }
        if (sum == G) break;
        __builtin_amdgcn_s_sleep(1);
        if ((++sp & 255u) == 0u) { if (xb_ld(&bar[XB_TMO])) break; if (sp > XB_SPIN_CAP) { atomicAdd(&bar[XB_TMO], 1u); break; } }
    }
    nloc = mine > 0u ? mine : 1u; nx = cnt > 0u ? cnt : 1u;
}

__device__ __forceinline__ void xcd_barrier(const XcdBarrier& b) {
    asm volatile("s_waitcnt vmcnt(0)" ::: "memory");
    __syncthreads();
    if (threadIdx.x == 0) {
        unsigned* bar = b.bar;
        __builtin_amdgcn_s_waitcnt(0);
        unsigned nloc = b.st[0], nx = b.st[1];
        if (nloc == 0u) { xcd_barrier_complete(bar, b.x, nloc, nx); b.st[0] = nloc; b.st[1] = nx; }
        const unsigned old = xb_add(&bar[XB_XSUB(b.x)], 1u);
        const unsigned gen = old / nloc;
        if (old + 1u == (gen + 1u) * nloc) {
            __builtin_amdgcn_fence(__ATOMIC_RELEASE, "agent");
            asm volatile("s_waitcnt vmcnt(0)" ::: "memory");
            const unsigned og = xb_add(&bar[XB_TOP], 1u);
            const unsigned tg = og / nx;
            if (og + 1u == (tg + 1u) * nx) xb_add(&bar[XB_TOPGEN], 1u);
            else XB_SPIN(xb_ld(&bar[XB_TOPGEN]) == tg, bar);
            __builtin_amdgcn_fence(__ATOMIC_ACQUIRE, "agent");
            xb_add(&bar[XB_XGEN(b.x)], 1u);
            asm volatile("s_waitcnt vmcnt(0)" ::: "memory");
        } else {
            XB_SPIN(xb_ld(&bar[XB_XGEN(b.x)]) == gen, bar);
            __builtin_amdgcn_fence(__ATOMIC_ACQUIRE, "agent");
            asm volatile("s_waitcnt vmcnt(0)" ::: "memory");
        }
    }
    __syncthreads();
}

using pg8::bf16_t; using pg8::bf16x8; using pg8::f32x4; using pg8::u32x4;
typedef unsigned u32x2 __attribute__((ext_vector_type(2)));
typedef float f32x2v __attribute__((ext_vector_type(2)));
constexpr int DM = 2048, DFF = 5632, INW = 16384;
constexpr int MP = 8192, MS = 128, MR = 8320, MPAD = 8448;
constexpr int NPHASE = 20;
constexpr float EPS = 1e-6f, LOG2E = 1.4426950408889634f;
constexpr float ATT_SC = 0.08838834764831845f * 1.4426950408889634f;
constexpr size_t O_Y = 0;
constexpr size_t O_KVP0 = (size_t)MR * DM;
constexpr size_t O_KVP1 = O_KVP0 + (size_t)2 * 4 * 128 * 1024;
constexpr size_t O_KVP2 = O_KVP1 + (size_t)2 * 4 * 512 * 1024;
constexpr size_t O_KVS0 = O_KVP2 + (size_t)2 * 4 * 2048 * 1024;
constexpr size_t O_KVS1 = O_KVS0 + (size_t)2 * 32 * 4 * 1024;
constexpr size_t O_KVS2 = O_KVS1 + (size_t)2 * 32 * 4 * 1024;
constexpr size_t O_POOLP = O_KVS2 + (size_t)2 * 32 * 4 * 1024;
constexpr size_t O_POOLS = O_POOLP + (size_t)2 * 4 * 15 * 512;
constexpr size_t O_RETP = O_POOLS + (size_t)2 * 32 * 15 * 512;
constexpr size_t O_RETS = O_RETP + (size_t)2 * 4 * 4 * 16384;
constexpr size_t O_GVS = O_RETS + (size_t)2 * 32 * 4 * 16384;
constexpr size_t O_END = O_GVS + (size_t)2 * 32 * 4 * 512;
static_assert(O_END == 45248512, "output map");
constexpr size_t MiB = 1u << 20;
constexpr size_t WS_CTL = 0, CTL_ZERO_BYTES = 1 * MiB;
constexpr size_t WS_ROT = 1 * MiB, WS_WPT = 3 * MiB, WS_W = 4 * MiB, W_LAYER = 212 * MiB;
constexpr size_t WL_GU1 = 0, WL_D1 = 44 * MiB, WL_IN = 66 * MiB, WL_B = 130 * MiB, WL_O = 138 * MiB, WL_GU2 = 146 * MiB, WL_D2 = 190 * MiB;
constexpr size_t WS_X = 428 * MiB, WS_XB = 494 * MiB, WS_G = 527 * MiB, WS_QKV = 618 * MiB, WS_BU = 693 * MiB, WS_BV = 702 * MiB, WS_CIN = 719 * MiB, WS_DR = 736 * MiB,
                 WS_GATE = 769 * MiB, WS_AO = 901 * MiB, WS_LSE = 926 * MiB, WS_BR = 927 * MiB, WS_LOC = 960 * MiB, WS_PM = 976 * MiB, WS_MG = 1042 * MiB, WS_XB8 = 1076 * MiB, WS_G8 = 1094 * MiB, WS_WD8 = 1142 * MiB, WS_END = 1190 * MiB;
constexpr int CW_BAR = 4096, CW_WQ = 12288, CW_SS = 16384;
static_assert(CW_SS * 4 + 9 * MPAD * 8 <= (int)CTL_ZERO_BYTES, "ctl");
constexpr int RING_BYTES = 131072, MISC_OFF = RING_BYTES + 320, LDS_BYTES = 147456;
constexpr int TS_ = 272, TILE = 128 * TS_;

__device__ const unsigned char BUCKET[3][132] = {
 {0,1,2,3,4,5,6,7,8,9,10,11,12,13,14,15,16,16,16,16,16,16,17,17,17,17,17,17,17,17,18,18,18,18,18,18,18,18,18,18,19,19,19,19,19,19,19,19,19,19,19,19,19,19,20,20,20,20,20,20,20,20,20,20,20,20,20,20,20,20,20,20,20,21,21,21,21,21,21,21,21,21,21,21,21,21,21,21,21,21,21,21,21,21,21,21,21,21,21,22,22,22,22,22,22,22,22,22,22,22,22,22,22,22,22,22,22,22,22,22,22,22,22,22,22,22,22,22,22,0,0,0},
 {0,4,8,12,16,16,17,17,18,18,19,19,19,19,20,20,20,20,20,21,21,21,21,21,21,22,22,22,22,22,22,22,22,22,23,23,23,23,23,23,23,23,23,23,23,23,24,24,24,24,24,24,24,24,24,24,24,24,24,24,24,24,25,25,25,25,25,25,25,25,25,25,25,25,25,25,25,25,25,25,25,25,25,26,26,26,26,26,26,26,26,26,26,26,26,26,26,26,26,26,26,26,26,26,26,26,26,26,26,26,26,26,26,27,27,27,27,27,27,27,27,27,27,27,27,27,27,27,27,0,0,0},
 {0,16,18,19,20,21,21,22,22,23,23,23,24,24,24,24,25,25,25,25,25,26,26,26,26,26,26,26,26,27,27,27,27,27,27,27,27,27,27,28,28,28,28,28,28,28,28,28,28,28,28,28,29,29,29,29,29,29,29,29,29,29,29,29,29,29,29,29,29,29,30,30,30,30,30,30,30,30,30,30,30,30,30,30,30,30,30,30,30,30,30,30,30,30,30,31,31,31,31,31,31,31,31,31,31,31,31,31,31,31,31,31,31,31,31,31,31,31,31,31,31,31,31,31,31,31,31,31,31,0,0,0}};

constexpr size_t W8_OFF = (size_t)36 << 20;
constexpr float X8_SCALE = 8.0f, W8_SCALE = 64.0f;
#ifndef FUSE_MIX
#define FUSE_MIX 1
#endif
#ifndef FUSE_FINAL
#define FUSE_FINAL 1
#endif
#ifndef SKIP_PM
#define SKIP_PM 32
#endif
#ifndef D8_MASK
#define D8_MASK 12
#endif
__device__ __forceinline__ unsigned pk4_fp8(float a, float b, float c, float d) { int w = __builtin_amdgcn_cvt_pk_fp8_f32(a, b, 0, false); w = __builtin_amdgcn_cvt_pk_fp8_f32(c, d, w, true); return (unsigned)w; }
__device__ __forceinline__ unsigned pk2(float lo, float hi) { return pg8::cvt_pk_bf16(lo, hi); }
__device__ __forceinline__ bf16_t f2bf(float f) { return (bf16_t)(pk2(f, f) & 0xffffu); }
__device__ __forceinline__ float bf2f(unsigned v) { return __uint_as_float(v << 16); }
__device__ __forceinline__ float bflo(unsigned w) { return __uint_as_float(w << 16); }
__device__ __forceinline__ float bfhi(unsigned w) { return __uint_as_float(w & 0xffff0000u); }
__device__ __forceinline__ float fast_rcp(float x) { return __builtin_amdgcn_rcpf(x); }
__device__ __forceinline__ float fexp2(float x) { return __builtin_amdgcn_exp2f(x); }
__device__ __forceinline__ float sigmoidf_(float x) { return fast_rcp(1.0f + fexp2(-LOG2E * x)); }
__device__ __forceinline__ float siluf_(float x) { return x * sigmoidf_(x); }
__device__ __forceinline__ float gelu_tanh(float x) { const float y = 0.7978845608028654f * (x + 0.044715f * x * x * x); return x * sigmoidf_(2.0f * y); }
__device__ __forceinline__ float wave_sum(float v) {
#pragma unroll
    for (int o = 1; o < 64; o <<= 1) v += __shfl_xor(v, o);
    return v;
}
__device__ __forceinline__ float wave_max(float v) {
#pragma unroll
    for (int o = 1; o < 64; o <<= 1) v = fmaxf(v, __shfl_xor(v, o));
    return v;
}
__device__ __forceinline__ float lg2gamma(int h) { return __log2f(1.0f - exp2f(-5.0f - (float)h)); }

struct Args { const float* in[27]; float* out; unsigned char* ws; int ph_lo, ph_hi; };
typedef const Args __attribute__((address_space(4)))* KArgs;
struct Ctx {
    LAS unsigned char* lds;
    int tid, lane, wave, G, bid;
    KArgs a;
    float* out; unsigned char* ws;
    u64* ssbase;
};
#define WSP(T, off) ((T*)(C.ws + (off)))

struct EpiGU {
    static constexpr bool PERM = true, AFTER_DRAIN = false, CARRY = false;
    bf16_t* G; const u64* ss; unsigned char* G8;
    __device__ __forceinline__ void operator()(const f32x4 (&acc)[2][2][4][2], const pg8::Unit& u, int wr, int wc, int fr, int fq) const {
        const int col0 = u.pn * 128 + wc * 32 + 8 * fq;
#pragma unroll
        for (int ai = 0; ai < 2; ++ai) {
            if (u.pm == 32 && ai == 1) break;
#pragma unroll
            for (int m = 0; m < 4; ++m) {
                const int row = u.pm * 256 + ai * 128 + wr * 64 + m * 16 + fr;
                const float r = rsqrtf(ss_get(ss + row) * (1.0f / DM) + EPS);
                float h[8];
#pragma unroll
                for (int n = 0; n < 2; ++n)
#pragma unroll
                    for (int e = 0; e < 4; ++e) { const float g = acc[ai][0][m][n][e] * r, up = acc[ai][1][m][n][e] * r; h[4 * n + e] = siluf_(g) * up; }
                u32x4 w; w.x = pk2(h[0], h[1]); w.y = pk2(h[2], h[3]); w.z = pk2(h[4], h[5]); w.w = pk2(h[6], h[7]);
                if (!G8) *(u32x4*)(G + (size_t)row * DFF + col0) = w;
                if (G8) { u32x2 w8; w8.x = pk4_fp8(h[0] * X8_SCALE, h[1] * X8_SCALE, h[2] * X8_SCALE, h[3] * X8_SCALE); w8.y = pk4_fp8(h[4] * X8_SCALE, h[5] * X8_SCALE, h[6] * X8_SCALE, h[7] * X8_SCALE); *(u32x2*)(G8 + (size_t)row * DFF + col0) = w8; }
            }
        }
    }
};
struct EpiRes {
    static constexpr bool PERM = true, AFTER_DRAIN = false, CARRY = false;
    float* X; bf16_t* XB; u64* ssn; unsigned char* XB8; float alpha;
    __device__ __forceinline__ void operator()(const f32x4 (&acc)[2][2][4][2], const pg8::Unit& u, int wr, int wc, int fr, int fq) const {
        const int col0 = u.pn * 256 + wc * 32 + 8 * fq;
#pragma unroll
        for (int ai = 0; ai < 2; ++ai) {
            if (u.pm == 32 && ai == 1) break;
#pragma unroll
            for (int m = 0; m < 4; ++m) {
                const int row = u.pm * 256 + ai * 128 + wr * 64 + m * 16 + fr;
                float s = 0.f;
#pragma unroll
                for (int bj = 0; bj < 2; ++bj) {
                    bf16_t* xbp = XB + (size_t)row * DM + col0 + bj * 128;
                    const u32x4 xo = *(const u32x4*)xbp;
                    f32x4 x0 = (f32x4){bflo(xo.x), bfhi(xo.x), bflo(xo.y), bfhi(xo.y)}, x1 = (f32x4){bflo(xo.z), bfhi(xo.z), bflo(xo.w), bfhi(xo.w)};
                    x0 += acc[ai][bj][m][0] * alpha; x1 += acc[ai][bj][m][1] * alpha;
                    u32x4 w; w.x = pk2(x0[0], x0[1]); w.y = pk2(x0[2], x0[3]); w.z = pk2(x1[0], x1[1]); w.w = pk2(x1[2], x1[3]);
                    *(u32x4*)xbp = w;
                    { const float a0 = x0[0] * X8_SCALE, a1 = x0[1] * X8_SCALE, a2 = x0[2] * X8_SCALE, a3 = x0[3] * X8_SCALE, a4 = x1[0] * X8_SCALE, a5 = x1[1] * X8_SCALE, a6 = x1[2] * X8_SCALE, a7 = x1[3] * X8_SCALE;
                      if (XB8) { const unsigned lo = pk4_fp8(a0, a1, a2, a3), hi = pk4_fp8(a4, a5, a6, a7); unsigned* p8 = (unsigned*)(XB8 + (size_t)row * DM + col0 + bj * 128); p8[0] = lo; p8[1] = hi; } }
                    s += (x0[0] * x0[0] + x0[1] * x0[1]) + (x0[2] * x0[2] + x0[3] * x0[3]) + (x1[0] * x1[0] + x1[1] * x1[1]) + (x1[2] * x1[2] + x1[3] * x1[3]);
                }
                s += __shfl_xor(s, 16); s += __shfl_xor(s, 32);
                if (fq == 0) ss_add(ssn + row, s);
            }
        }
    }
};
struct EpiResFinal {
    static constexpr bool PERM = true, AFTER_DRAIN = true, CARRY = false;
    const bf16_t* XB; u64* ssn; const float* gain; float* out; unsigned* cnt; unsigned* bar; float alpha;
    __device__ __forceinline__ void fused(f32x4 (&acc)[2][2][4][2], const pg8::Unit& u, int wr, int wc, int fr, int fq, LAS unsigned char*, int, int) const {
        const int col0 = u.pn * 256 + wc * 32 + 8 * fq;
#pragma unroll
        for (int ai = 0; ai < 2; ++ai)
#pragma unroll
            for (int m = 0; m < 4; ++m) {
                const int row = u.pm * 256 + ai * 128 + wr * 64 + m * 16 + fr;
                float s = 0.f;
#pragma unroll
                for (int bj = 0; bj < 2; ++bj) {
                    const u32x4 xo = *(const u32x4*)(XB + (size_t)row * DM + col0 + bj * 128);
                    const f32x4 x0 = (f32x4){bflo(xo.x), bfhi(xo.x), bflo(xo.y), bfhi(xo.y)} + acc[ai][bj][m][0] * alpha, x1 = (f32x4){bflo(xo.z), bfhi(xo.z), bflo(xo.w), bfhi(xo.w)} + acc[ai][bj][m][1] * alpha;
                    acc[ai][bj][m][0] = x0; acc[ai][bj][m][1] = x1;
                    s += (x0[0] * x0[0] + x0[1] * x0[1]) + (x0[2] * x0[2] + x0[3] * x0[3]) + (x1[0] * x1[0] + x1[1] * x1[1]) + (x1[2] * x1[2] + x1[3] * x1[3]);
                }
                s += __shfl_xor(s, 16); s += __shfl_xor(s, 32);
                if (fq == 0) ss_add(ssn + row, s);
            }
        asm volatile("s_waitcnt vmcnt(0)" ::: "memory");
        __syncthreads();
        if (threadIdx.x == 0) {
            __builtin_amdgcn_fence(__ATOMIC_RELEASE, "agent"); asm volatile("s_waitcnt vmcnt(0)" ::: "memory");
            (void)xb_add(cnt + u.pm, 1u);
            XB_SPIN(xb_ld(cnt + u.pm) < 8u, bar);
            __builtin_amdgcn_fence(__ATOMIC_ACQUIRE, "agent"); asm volatile("s_waitcnt vmcnt(0)" ::: "memory");
        }
        __syncthreads();
#pragma unroll
        for (int ai = 0; ai < 2; ++ai)
#pragma unroll
            for (int m = 0; m < 4; ++m) {
                const int row = u.pm * 256 + ai * 128 + wr * 64 + m * 16 + fr;
                const float r = rsqrtf(ss_get(ssn + row) * (1.0f / DM) + EPS);
#pragma unroll
                for (int bj = 0; bj < 2; ++bj) {
                    const int col = col0 + bj * 128; const f32x4 g0 = *(const f32x4*)(gain + col), g1 = *(const f32x4*)(gain + col + 4);
                    float* yp = out + (size_t)row * DM + col;
                    *(f32x4*)yp = acc[ai][bj][m][0] * r * g0; *(f32x4*)(yp + 4) = acc[ai][bj][m][1] * r * g1;
                }
            }
    }
};
struct EpiMerge {
    static constexpr bool PERM = true, AFTER_DRAIN = false, CARRY = true;
    const bf16_t* GATE; bf16_t* MG; int layer;
    __device__ __forceinline__ void operator()(f32x4 (&acc)[2][2][4][2], const pg8::Unit& u, int wr, int wc, int fr, int fq) const {
        const int nbr = u.pn >> 3, upn = u.pn & 7, upm = u.pm - (MPAD / 256) * nbr;
        const int col0 = upn * 256 + wc * 32 + 8 * fq;
#pragma unroll
        for (int ai = 0; ai < 2; ++ai) {
#pragma unroll
            for (int m = 0; m < 4; ++m) {
                const int row = upm * 256 + ai * 128 + wr * 64 + m * 16 + fr;
#pragma unroll
                for (int bj = 0; bj < 2; ++bj) {
                    const int col = col0 + bj * 128;
                    const bf16_t* gp = GATE + (size_t)row * 8192 + nbr * 2048 + col;
                    const u32x4 gw = *(const u32x4*)gp;
                    f32x4 v0 = acc[ai][bj][m][0], v1 = acc[ai][bj][m][1];
                    v0[0] *= bflo(gw.x); v0[1] *= bfhi(gw.x); v0[2] *= bflo(gw.y); v0[3] *= bfhi(gw.y);
                    v1[0] *= bflo(gw.z); v1[1] *= bfhi(gw.z); v1[2] *= bflo(gw.w); v1[3] *= bfhi(gw.w);
                    if (nbr < 3) { acc[ai][bj][m][0] = v0; acc[ai][bj][m][1] = v1;
                    } else { u32x4 w; w.x = pk2(v0[0], v0[1]); w.y = pk2(v0[2], v0[3]); w.z = pk2(v1[0], v1[1]); w.w = pk2(v1[2], v1[3]); *(u32x4*)(MG + (size_t)row * DM + col) = w; }
                }
            }
        }
    }
};
struct EpiGate {
    static constexpr bool PERM = true, AFTER_DRAIN = false, CARRY = false;
    const u64* ss; bf16_t* GATE; bf16_t* QKV;
    __device__ __forceinline__ void operator()(const f32x4 (&acc)[2][2][4][2], const pg8::Unit& u, int wr, int wc, int fr, int fq) const {
        const int cl = wc * 32 + 8 * fq;
#pragma unroll
        for (int ai = 0; ai < 2; ++ai) {
            if (u.pm == 32 && ai == 1) break;
#pragma unroll
            for (int m = 0; m < 4; ++m) {
                const int row = u.pm * 256 + ai * 128 + wr * 64 + m * 16 + fr;
                const float r = rsqrtf(ss_get(ss + row) * (1.0f / DM) + EPS) * (1.0f / (X8_SCALE * W8_SCALE));
                if (u.pn < 6) {
#pragma unroll
                    for (int bj = 0; bj < 2; ++bj) {
                        const f32x4 a = acc[ai][bj][m][0] * r, b = acc[ai][bj][m][1] * r;
                        u32x4 w; w.x = pk2(a[0], a[1]); w.y = pk2(a[2], a[3]); w.z = pk2(b[0], b[1]); w.w = pk2(b[2], b[3]);
                        *(u32x4*)(QKV + (size_t)row * 4608 + u.pn * 256 + bj * 128 + cl) = w;
                    }
                } else {
                    f32x4 g[4];
#pragma unroll
                    for (int b = 0; b < 4; ++b)
#pragma unroll
                        for (int e = 0; e < 4; ++e) g[b][e] = sigmoidf_(acc[ai][b >> 1][m][b & 1][e] * r);
                    bf16_t* gp = GATE + (size_t)row * 8192 + (u.pn - 6) * 64 + wc * 16 + 4 * fq;
#pragma unroll
                    for (int b = 0; b < 4; ++b) {
                        f32x4 h = g[b];
                        if (b < 3) {
#pragma unroll
                            for (int e = 0; e < 4; ++e) h[e] *= __builtin_amdgcn_rcpf(fmaxf(g[b + 1][e], 1e-30f));
                        }
                        u32x2 w; w.x = pk2(h[0], h[1]); w.y = pk2(h[2], h[3]); *(u32x2*)(gp + b * 2048) = w;
                    }
                }
            }
        }
    }
};
struct EpiIn {
    static constexpr bool PERM = true, AFTER_DRAIN = false, CARRY = false;
    const u64* ss; bf16_t* QKV; bf16_t* BU; float* BV; float* CIN; bf16_t* DR; bf16_t* GATE; u64* ssv; const float* ROT; float* out; int layer; int pn0;
    __device__ __forceinline__ void operator()(const f32x4 (&acc)[2][2][4][2], const pg8::Unit& u, int wr, int wc, int fr, int fq) const {
        const int pn = u.pn + pn0, cl = wc * 32 + 8 * fq;
#pragma unroll
        for (int ai = 0; ai < 2; ++ai) {
            if (u.pm == 32 && ai == 1) break;
#pragma unroll
            for (int m = 0; m < 4; ++m) {
                const int row = u.pm * 256 + ai * 128 + wr * 64 + m * 16 + fr;
                const float r = rsqrtf(ss_get(ss + row) * (1.0f / DM) + EPS);
                const bool samp = row >= MP; const int rs = row - MP;
                f32x4 v[2][2];
#pragma unroll
                for (int bj = 0; bj < 2; ++bj)
#pragma unroll
                    for (int n = 0; n < 2; ++n) v[bj][n] = acc[ai][bj][m][n] * r;
                if (pn < 18) {
#pragma unroll
                    for (int bj = 0; bj < 2; ++bj) {
                        u32x4 w; w.x = pk2(v[bj][0][0], v[bj][0][1]); w.y = pk2(v[bj][0][2], v[bj][0][3]); w.z = pk2(v[bj][1][0], v[bj][1][1]); w.w = pk2(v[bj][1][2], v[bj][1][3]);
                        *(u32x4*)(QKV + (size_t)row * 4608 + pn * 256 + bj * 128 + cl) = w;
                    }
                    if (pn >= 6) {
                        const int kv = pn >= 12 ? 1 : 0, x = pn - 6 - 6 * kv, gi = x >> 1, hp = x & 1, keep = 128 << (2 * gi);
                        long off = -1;
                        if (!samp) { const int b = row >> 11, t = row & 2047, tp = t - (2048 - keep);
                            if (tp >= 0) off = (long)(gi == 0 ? O_KVP0 : (gi == 1 ? O_KVP1 : O_KVP2)) + ((((long)(layer * 4 + b) * keep + tp) * 2 + kv) * 4 + 2 * hp) * 128 + cl; }
                        else { const int b = rs >> 2, s = rs & 3; off = (long)(gi == 0 ? O_KVS0 : (gi == 1 ? O_KVS1 : O_KVS2)) + ((((long)(layer * 32 + b) * 4 + s) * 2 + kv) * 4 + 2 * hp) * 128 + cl; }
                        if (off >= 0) {
#pragma unroll
                            for (int bj = 0; bj < 2; ++bj) { *(f32x4*)(out + off + bj * 128) = v[bj][0]; *(f32x4*)(out + off + bj * 128 + 4) = v[bj][1]; }
                        }
                    }
                } else if (pn < 20) {
#pragma unroll
                    for (int bj = 0; bj < 2; ++bj) {
                        float h[8];
#pragma unroll
                        for (int n = 0; n < 2; ++n)
#pragma unroll
                            for (int e = 0; e < 4; ++e) h[4 * n + e] = gelu_tanh(v[bj][n][e]);
                        u32x4 w; w.x = pk2(h[0], h[1]); w.y = pk2(h[2], h[3]); w.z = pk2(h[4], h[5]); w.w = pk2(h[6], h[7]);
                        *(u32x4*)(BU + (size_t)row * 512 + (pn - 18) * 256 + bj * 128 + cl) = w;
                    }
                } else if (pn < 22) {
                    float s = 0.f;
#pragma unroll
                    for (int bj = 0; bj < 2; ++bj) {
                        f32x4 h0, h1;
#pragma unroll
                        for (int e = 0; e < 4; ++e) { h0[e] = gelu_tanh(v[bj][0][e]); h1[e] = gelu_tanh(v[bj][1][e]); s += h0[e] * h0[e] + h1[e] * h1[e]; }
                        float* p = BV + (size_t)row * 512 + (pn - 20) * 256 + bj * 128 + cl;
                        *(f32x4*)p = h0; *(f32x4*)(p + 4) = h1;
                    }
                    s += __shfl_xor(s, 16); s += __shfl_xor(s, 32);
                    if (fq == 0) ss_add(ssv + row, s);
                } else if (pn < 24) {
                    const int c0 = (pn - 22) * 256 + cl;
                    long off = -1;
                    if (!samp) { const int b = row >> 11, t = row & 2047; if (t >= 2033) off = (long)O_POOLP + ((long)(layer * 4 + b) * 15 + (t - 2033)) * 512 + c0; }
                    else { const int b = rs >> 2, s = rs & 3; off = (long)O_POOLS + ((long)(layer * 32 + b) * 15 + 11 + s) * 512 + c0; }
#pragma unroll
                    for (int bj = 0; bj < 2; ++bj) {
                        float* p = CIN + (size_t)row * 512 + c0 + bj * 128;
                        *(f32x4*)p = v[bj][0]; *(f32x4*)(p + 4) = v[bj][1];
                        if (off >= 0) { *(f32x4*)(out + off + bj * 128) = v[bj][0]; *(f32x4*)(out + off + bj * 128 + 4) = v[bj][1]; }
                    }
                } else if (pn < 28) {
                    const int which = (pn - 24) >> 1, hp = (pn - 24) & 1, j0 = 16 * wc + 4 * fq;
                    const int pidx = samp ? 2048 + (rs & 3) : (row & 2047);
                    const f32x4 cs0 = *(const f32x4*)(ROT + ((size_t)pidx * 64 + j0) * 2), cs1 = *(const f32x4*)(ROT + ((size_t)pidx * 64 + j0) * 2 + 4);
                    const float cc[4] = {cs0[0], cs0[2], cs1[0], cs1[2]}, sn[4] = {cs0[1], cs0[3], cs1[1], cs1[3]};
                    const float ks = which ? 0.08838834764831845f : 1.0f;
#pragma unroll
                    for (int bj = 0; bj < 2; ++bj) {
                        float o1[4], o2[4];
#pragma unroll
                        for (int e = 0; e < 4; ++e) { const float x1 = v[bj][0][e], x2 = v[bj][1][e]; o1[e] = (x1 * cc[e] - x2 * sn[e]) * ks; o2[e] = (x1 * sn[e] + x2 * cc[e]) * ks; }
                        bf16_t* p = DR + (size_t)row * 2048 + which * 512 + (2 * hp + bj) * 128 + j0;
                        u32x2 w1, w2; w1.x = pk2(o1[0], o1[1]); w1.y = pk2(o1[2], o1[3]); w2.x = pk2(o2[0], o2[1]); w2.y = pk2(o2[2], o2[3]);
                        *(u32x2*)p = w1; *(u32x2*)(p + 64) = w2;
                    }
                } else if (pn < 32) {
                    const bool isg = pn >= 30;
#pragma unroll
                    for (int bj = 0; bj < 2; ++bj) {
                        float h[8];
#pragma unroll
                        for (int n = 0; n < 2; ++n)
#pragma unroll
                            for (int e = 0; e < 4; ++e) h[4 * n + e] = isg ? siluf_(v[bj][n][e]) : v[bj][n][e];
                        u32x4 w; w.x = pk2(h[0], h[1]); w.y = pk2(h[2], h[3]); w.z = pk2(h[4], h[5]); w.w = pk2(h[6], h[7]);
                        *(u32x4*)(DR + (size_t)row * 2048 + 1024 + (pn - 28) * 256 + bj * 128 + cl) = w;
                    }
                } else {
#pragma unroll
                    for (int bj = 0; bj < 2; ++bj) {
                        float h[8];
#pragma unroll
                        for (int n = 0; n < 2; ++n)
#pragma unroll
                            for (int e = 0; e < 4; ++e) h[4 * n + e] = sigmoidf_(v[bj][n][e]);
                        u32x4 w; w.x = pk2(h[0], h[1]); w.y = pk2(h[2], h[3]); w.z = pk2(h[4], h[5]); w.w = pk2(h[6], h[7]);
                        *(u32x4*)(GATE + (size_t)row * 8192 + (pn - 32) * 256 + bj * 128 + cl) = w;
                    }
                }
            }
        }
    }
};

__device__ __forceinline__ void conv_item(const float* src, int ld, int col4, const float* gain, bf16_t* dst, int K, int R0, int k0, LAS float* scr, int lane, unsigned char* dst8 = nullptr) {
    const int kr = lane >> 3, c4 = lane & 7;
    f32x4 v[8];
#pragma unroll
    for (int i = 0; i < 8; ++i) v[i] = __builtin_nontemporal_load((const f32x4*)(src + (size_t)(k0 + 8 * i + kr) * ld + col4));
#pragma unroll
    for (int i = 0; i < 8; ++i) { const float gk = gain ? gain[k0 + 8 * i + kr] : 1.0f; LAS float* s = scr + (8 * i + kr) * 33 + 4 * c4; s[0] = v[i][0] * gk; s[1] = v[i][1] * gk; s[2] = v[i][2] * gk; s[3] = v[i][3] * gk; }
    asm volatile("s_waitcnt lgkmcnt(0)" ::: "memory");
    const int c = lane & 7;
#pragma unroll
    for (int j = 0; j < 4; ++j) { const int n = (lane >> 3) + 8 * j; const LAS float* s = scr + (8 * c) * 33 + n;
        u32x4 o; o.x = pk2(s[0 * 33], s[1 * 33]); o.y = pk2(s[2 * 33], s[3 * 33]); o.z = pk2(s[4 * 33], s[5 * 33]); o.w = pk2(s[6 * 33], s[7 * 33]);
        if (dst) *(u32x4*)(dst + (size_t)(R0 + n) * K + k0 + 8 * c) = o;
        if (dst8) { u32x2 o8; o8.x = pk4_fp8(s[0 * 33] * W8_SCALE, s[1 * 33] * W8_SCALE, s[2 * 33] * W8_SCALE, s[3 * 33] * W8_SCALE); o8.y = pk4_fp8(s[4 * 33] * W8_SCALE, s[5 * 33] * W8_SCALE, s[6 * 33] * W8_SCALE, s[7 * 33] * W8_SCALE);
            *(u32x2*)(dst8 + (size_t)(R0 + n) * K + k0 + 8 * c) = o8; } }
    asm volatile("s_waitcnt lgkmcnt(0)" ::: "memory");
}
__device__ __forceinline__ void conv_item8(const float* src, int ld, int col4, const float* gain, unsigned char* dst8, int R0, int k0, LAS float* scr, int lane) {
    const int kr = lane >> 3, c4 = lane & 7;
    f32x4 v[8];
#pragma unroll
    for (int i = 0; i < 8; ++i) v[i] = __builtin_nontemporal_load((const f32x4*)(src + (size_t)(k0 + 8 * i + kr) * ld + col4));
#pragma unroll
    for (int i = 0; i < 8; ++i) { const float gk = gain[k0 + 8 * i + kr] * W8_SCALE; LAS float* sp = scr + (8 * i + kr) * 33 + 4 * c4; sp[0] = v[i][0] * gk; sp[1] = v[i][1] * gk; sp[2] = v[i][2] * gk; sp[3] = v[i][3] * gk; }
    asm volatile("s_waitcnt lgkmcnt(0)" ::: "memory");
    const int c = lane & 7;
#pragma unroll
    for (int j = 0; j < 4; ++j) { const int n = (lane >> 3) + 8 * j; const LAS float* sp = scr + (8 * c) * 33 + n;
        u32x2 o; o.x = pk4_fp8(sp[0 * 33], sp[1 * 33], sp[2 * 33], sp[3 * 33]); o.y = pk4_fp8(sp[4 * 33], sp[5 * 33], sp[6 * 33], sp[7 * 33]);
        *(u32x2*)(dst8 + (size_t)(R0 + n) * 2048 + k0 + 8 * c) = o; }
    asm volatile("s_waitcnt lgkmcnt(0)" ::: "memory");
}
__device__ __forceinline__ void p_prologue(Ctx& C) {
    LAS float* scr = (LAS float*)(C.lds + C.wave * 8448);
    const int gw = C.bid * 8 + C.wave, NGW = C.G * 8, lane = C.lane, c4 = lane & 7;
    constexpr int I_GU = 32 * 352, I_D = 88 * 64, I_IN = 32 * 512, I_B = 4 * 8 * 64, I_O = 32 * 64, I_L = 2 * I_GU + 2 * I_D + I_IN + I_B + I_O;
    constexpr int NITEMS = 2 * I_L + 64;
    for (int it = gw; it < NITEMS; it += NGW) {
        if (it >= 2 * I_L) {
            const int x = it - 2 * I_L, mt = x >> 3, y = x & 7, kb = y >> 2, nb = y & 3;
            conv_item(C.a->in[17] + (size_t)mt * 16384, 128, nb * 32 + 4 * c4, nullptr, WSP(bf16_t, WS_WPT) + (size_t)mt * 16384, 128, nb * 32, kb * 64, scr, lane); continue; }
        const int l = it / I_L; int r = it % I_L; unsigned char* wl = C.ws + WS_W + (size_t)l * W_LAYER;
        if (r < 2 * I_GU) {
            const int second = r >= I_GU; if (second) r -= I_GU;
            const int kb = r / 352, nb = r % 352, R0 = nb * 32, hid = (R0 >> 8) * 128 + (R0 & 127), isup = (R0 >> 7) & 1;
            const float* src = (second ? (isup ? C.a->in[24] : C.a->in[23]) : (isup ? C.a->in[10] : C.a->in[9])) + (size_t)l * DM * DFF; const float* gain = (second ? C.a->in[22] : C.a->in[8]) + l * DM;
            conv_item(src, DFF, hid + 4 * c4, gain, (bf16_t*)(wl + (second ? WL_GU2 : WL_GU1)), DM, R0, kb * 64, scr, lane); continue; }
        r -= 2 * I_GU;
        if (r < 2 * I_D) { const int second = r >= I_D; if (second) r -= I_D; const int kb = r / 64, nb = r % 64;
            conv_item((second ? C.a->in[25] : C.a->in[11]) + (size_t)l * DFF * DM, DM, nb * 32 + 4 * c4, nullptr, ((D8_MASK >> (2 * l + second)) & 1) ? (bf16_t*)nullptr : (bf16_t*)(wl + (second ? WL_D2 : WL_D1)), DFF, nb * 32, kb * 64, scr, lane,
                      ((D8_MASK >> (2 * l + second)) & 1) ? C.ws + WS_WD8 + (size_t)(2 * l + second) * (12u << 20) : nullptr); continue; }
        r -= 2 * I_D;
        if (r < I_IN) { const int kb = r / 512, nb = r % 512, R0 = nb * 32; int col = R0 + 4 * c4;
            if (R0 >= 6144 && R0 < 7168) { const int hb = R0 & ~127, wc = (R0 & 127) >> 5, fq = c4 >> 1, n = c4 & 1; col = hb + 16 * wc + 4 * fq + 64 * n; }
            if (R0 >= 8192) { const int d = R0 - 8192, pg = d >> 8, bj = (d >> 7) & 1, wc = (d >> 5) & 3, fq = c4 >> 1, n = c4 & 1;
                col = 8192 + (2 * bj + n) * 2048 + 64 * pg + 16 * wc + 4 * fq; }
            if (R0 < 1536 || R0 >= 8192) conv_item8(C.a->in[13] + (size_t)l * DM * INW, INW, col, C.a->in[12] + l * DM, wl + WL_IN + W8_OFF, R0 < 1536 ? R0 : R0 - 8192 + 1536, kb * 64, scr, lane);
            else conv_item(C.a->in[13] + (size_t)l * DM * INW, INW, col, C.a->in[12] + l * DM, (bf16_t*)(wl + WL_IN), DM, R0, kb * 64, scr, lane);
            continue; }
        r -= I_IN;
        if (r < I_B) { const int n = r / 512, y = r % 512, kb = y / 64, nb = y % 64;
            conv_item(C.a->in[20] + ((size_t)l * 4 + n) * 512 * DM, DM, nb * 32 + 4 * c4, nullptr, (bf16_t*)(wl + WL_B) + (size_t)n * DM * 512, 512, nb * 32, kb * 64, scr, lane); continue; }
        r -= I_B;
        { const int kb = r / 64, nb = r % 64;
          conv_item(C.a->in[21] + (size_t)l * DM * DM, DM, nb * 32 + 4 * c4, nullptr, (bf16_t*)(wl + WL_O), DM, nb * 32, kb * 64, scr, lane); }
    }
    float* X = WSP(float, WS_X); bf16_t* XB = WSP(bf16_t, WS_XB); u64* ss0 = C.ssbase;
    for (int row = gw; row < MR; row += NGW) {
        const float* src = row < MP ? C.a->in[0] + (size_t)row * DM : C.a->in[1] + (size_t)(row - MP) * DM;
        float s = 0.f;
#pragma unroll
        for (int j = 0; j < 8; ++j) { const f32x4 v = *(const f32x4*)(src + j * 256 + lane * 4); if (row >= MP) *(f32x4*)(X + (size_t)row * DM + j * 256 + lane * 4) = v;
            u32x2 w; w.x = pk2(v[0], v[1]); w.y = pk2(v[2], v[3]); *(u32x2*)(XB + (size_t)row * DM + j * 256 + lane * 4) = w; s += (v[0] * v[0] + v[1] * v[1]) + (v[2] * v[2] + v[3] * v[3]); }
        s = wave_sum(s); if (lane == 0) ss0[row] = ss_fix(s);
    }
    float* ROT = WSP(float, WS_ROT);
    for (int i = C.bid * 512 + C.tid; i < 2052 * 64; i += C.G * 512) {
        const int p = i >> 6, j = i & 63; const double pos = p < 2048 ? (double)p : (double)(8192 + p - 2048);
        double inv = 1.0; for (int q = 0; q < j; ++q) inv *= 0.86596432336006535;
        const double ang = pos * inv, n = __builtin_rint(ang * 0.15915494309189535);
        double rr = __builtin_fma(-n, 6.283185307179586, ang); rr = __builtin_fma(-n, 2.4492935982947064e-16, rr);
        const double h = 0.5 * rr, h2 = h * h;
        double sp = 1.0 / 51090942171709440000.0, cp = 1.0 / 1124000727777607680000.0;
        sp = sp * h2 - 1.0 / 121645100408832000.0; sp = sp * h2 + 1.0 / 355687428096000.0; sp = sp * h2 - 1.0 / 1307674368000.0; sp = sp * h2 + 1.0 / 6227020800.0; sp = sp * h2 - 1.0 / 39916800.0;
        sp = sp * h2 + 1.0 / 362880.0; sp = sp * h2 - 1.0 / 5040.0; sp = sp * h2 + 1.0 / 120.0; sp = sp * h2 - 1.0 / 6.0; sp = sp * h2 + 1.0; sp *= h;
        cp = -cp * h2 + 1.0 / 2432902008176640000.0; cp = cp * h2 - 1.0 / 6402373705728000.0; cp = cp * h2 + 1.0 / 20922789888000.0; cp = cp * h2 - 1.0 / 87178291200.0; cp = cp * h2 + 1.0 / 479001600.0;
        cp = cp * h2 - 1.0 / 3628800.0; cp = cp * h2 + 1.0 / 40320.0; cp = cp * h2 - 1.0 / 720.0; cp = cp * h2 + 1.0 / 24.0; cp = cp * h2 - 0.5; cp = cp * h2 + 1.0;
        ROT[2 * i] = (float)(1.0 - 2.0 * sp * sp); ROT[2 * i + 1] = (float)(2.0 * sp * cp);
    }
}

template <int NB, int KS>
__device__ __forceinline__ void wave_gemm_nt(const LAS unsigned char* A, const LAS unsigned char* BT, f32x4 (&acc)[NB], int lane) {
    const int r = lane & 15, q = lane >> 4;
#pragma unroll
    for (int ks = 0; ks < KS; ++ks) {
        const bf16x8 a = *(const LAS bf16x8*)(A + r * TS_ + ks * 64 + q * 16);
#pragma unroll
        for (int nb = 0; nb < NB; ++nb) { const bf16x8 b = *(const LAS bf16x8*)(BT + (nb * 16 + r) * TS_ + ks * 64 + q * 16); acc[nb] = __builtin_amdgcn_mfma_f32_16x16x32_bf16(b, a, acc[nb], 0, 0, 0); }
    }
}
template <int NB, int KS>
__device__ __forceinline__ void wave_gemm_nt_areg(const bf16x8 (&af)[KS], const LAS unsigned char* BT, f32x4 (&acc)[NB], int lane) {
    const int r = lane & 15, q = lane >> 4;
#pragma unroll
    for (int ks = 0; ks < KS; ++ks) {
#pragma unroll
        for (int nb = 0; nb < NB; ++nb) { const bf16x8 b = *(const LAS bf16x8*)(BT + (nb * 16 + r) * TS_ + ks * 64 + q * 16); acc[nb] = __builtin_amdgcn_mfma_f32_16x16x32_bf16(b, af[ks], acc[nb], 0, 0, 0); }
    }
}
__device__ __forceinline__ void tile_load_nat(LAS unsigned char* dst, const bf16_t* src, size_t row0, int rstride, int ld, int tid) {
#pragma unroll
    for (int it = 0; it < 4; ++it) { const int idx = tid + it * 512, i = idx >> 4, ch = idx & 15;
        const u32x4 v = *(const u32x4*)(src + (row0 + (size_t)i * rstride) * ld + ch * 8); *(LAS u32x4*)(dst + i * TS_ + ch * 16) = v; }
}
template <bool SCALE>
__device__ __forceinline__ void tile_load_T(LAS unsigned char* dst, const bf16_t* src, size_t row0, int rstride, int ld, int tid, float rowscale) {
    const int i = tid & 127, cq = tid >> 7;
#pragma unroll
    for (int it = 0; it < 4; ++it) { const int ch = cq + 4 * it;
        const u32x4 v = *(const u32x4*)(src + (row0 + (size_t)i * rstride) * ld + ch * 8);
        const unsigned w[4] = {v.x, v.y, v.z, v.w};
#pragma unroll
        for (int e = 0; e < 4; ++e) { unsigned lo = w[e] & 0xffffu, hi = w[e] >> 16;
            if (SCALE) { const unsigned p = pk2(bf2f(lo) * rowscale, bf2f(hi) * rowscale); lo = p & 0xffffu; hi = p >> 16; }
            *(LAS bf16_t*)(dst + (ch * 8 + 2 * e) * TS_ + i * 2) = (bf16_t)lo; *(LAS bf16_t*)(dst + (ch * 8 + 2 * e + 1) * TS_ + i * 2) = (bf16_t)hi; }
    }
}
__device__ __forceinline__ void store_p_rows(LAS unsigned char* P, const f32x4 (&p)[8], int lane) {
    const int r = lane & 15, q = lane >> 4;
#pragma unroll
    for (int nb = 0; nb < 8; ++nb) { u32x2 w; w.x = pk2(p[nb][0], p[nb][1]); w.y = pk2(p[nb][2], p[nb][3]); *(LAS u32x2*)(P + r * TS_ + (nb * 16 + 4 * q) * 2) = w; }
}

__device__ __forceinline__ void attn_unit(Ctx& C, int b, int g, int h, int r, int qb) {
    const int tid = C.tid, lane = C.lane, wave = C.wave, q4 = lane >> 4, dil = 1 << (2 * g);
    LAS unsigned char* Ks = C.lds; LAS unsigned char* VT = C.lds + TILE; LAS unsigned char* Ps = C.lds + 2 * TILE + wave * 16 * TS_; LAS float* biasL = (LAS float*)(C.lds + 3 * TILE);
    const bf16_t* QKV = WSP(bf16_t, WS_QKV);
    __syncthreads();
    if (tid < 129) biasL[tid] = C.a->in[7][BUCKET[g][tid] * 12 + g * 4 + h] * LOG2E;
    const int iq = wave * 16 + (lane & 15); const size_t qrow = (size_t)b * 2048 + r + dil * (128 * qb + iq);
    bf16x8 qf[4];
#pragma unroll
    for (int ks = 0; ks < 4; ++ks) qf[ks] = *(const bf16x8*)(QKV + qrow * 4608 + g * 512 + h * 128 + ks * 32 + q4 * 8);
    float mrun = -INFINITY, lrun = 0.f; f32x4 o[8];
#pragma unroll
    for (int nb = 0; nb < 8; ++nb) o[nb] = (f32x4){0.f, 0.f, 0.f, 0.f};
    const int kb0 = qb > 0 ? qb - 1 : 0;
    for (int kb = kb0; kb <= qb; ++kb) {
        if (kb != kb0) __syncthreads();
        const size_t krow0 = (size_t)b * 2048 + r + (size_t)dil * 128 * kb;
        tile_load_nat(Ks, QKV + 1536 + g * 512 + h * 128, krow0, dil, 4608, tid);
        tile_load_T<false>(VT, QKV + 3072 + g * 512 + h * 128, krow0, dil, 4608, tid, 1.f);
        __syncthreads();
        f32x4 s[8];
#pragma unroll
        for (int nb = 0; nb < 8; ++nb) s[nb] = (f32x4){0.f, 0.f, 0.f, 0.f};
        wave_gemm_nt_areg<8, 4>(qf, Ks, s, lane);
        const int joff = 128 * (qb - kb) + iq; float mx = -INFINITY;
#pragma unroll
        for (int nb = 0; nb < 8; ++nb)
#pragma unroll
            for (int i = 0; i < 4; ++i) { const int j = joff - (nb * 16 + 4 * q4 + i); const bool ok = (j >= 0) && (j <= 128); const int jc = j < 0 ? 0 : (j > 128 ? 128 : j);
                const float val = ok ? s[nb][i] * ATT_SC + biasL[jc] : -INFINITY; s[nb][i] = val; mx = fmaxf(mx, val); }
        mx = fmaxf(mx, __shfl_xor(mx, 16)); mx = fmaxf(mx, __shfl_xor(mx, 32));
        const float mn = fmaxf(mrun, mx), alpha = (mrun == -INFINITY) ? 0.f : fexp2(mrun - mn); float rs = 0.f;
#pragma unroll
        for (int nb = 0; nb < 8; ++nb)
#pragma unroll
            for (int i = 0; i < 4; ++i) { const float p = (s[nb][i] == -INFINITY) ? 0.f : fexp2(s[nb][i] - mn); s[nb][i] = p; rs += p; }
        rs += __shfl_xor(rs, 16); rs += __shfl_xor(rs, 32);
        lrun = lrun * alpha + rs; mrun = mn;
#pragma unroll
        for (int nb = 0; nb < 8; ++nb) o[nb] *= alpha;
        store_p_rows(Ps, s, lane);
        wave_gemm_nt<8, 4>(Ps, VT, o, lane);
    }
    const float inv = 1.0f / lrun;
    bf16_t* AO = WSP(bf16_t, WS_AO) + ((size_t)g * MPAD + qrow) * 512 + h * 128;
#pragma unroll
    for (int nb = 0; nb < 8; ++nb) { u32x2 w; w.x = pk2(o[nb][0] * inv, o[nb][1] * inv); w.y = pk2(o[nb][2] * inv, o[nb][3] * inv); *(u32x2*)(AO + nb * 16 + 4 * q4) = w; }
    if (q4 == 0) WSP(float, WS_LSE)[((size_t)g * MPAD + qrow) * 4 + h] = mrun + __log2f(lrun);
}
__device__ __forceinline__ void attn_sample_item(Ctx& C, int layer, int it) {
    const int lane = C.lane, wave = C.wave;
    LAS float* wl = (LAS float*)(C.lds + wave * 2048); LAS float* ql = wl; LAS float* pl = wl + 128; LAS float* ol = wl + 264;
    const bf16_t* QKV = WSP(bf16_t, WS_QKV);
    const int tr = it * 2 + (wave >= 3 ? 1 : 0), g = wave % 3, b = tr >> 4, s = (tr >> 2) & 3, h = tr & 3;
    if (wave < 6) {
        const size_t row = MP + b * 4 + s; const int win = 128 << (2 * g), dil = 1 << (2 * g);
        const float* cache = (g == 0 ? C.a->in[2] : (g == 1 ? C.a->in[3] : C.a->in[4])) + (size_t)(layer * 32 + b) * win * 1024 + h * 128;
        { const unsigned w = *(const unsigned*)(QKV + row * 4608 + g * 512 + h * 128 + 2 * lane); ql[2 * lane] = bflo(w); ql[2 * lane + 1] = bfhi(w); }
        asm volatile("s_waitcnt lgkmcnt(0)" ::: "memory");
        float sc[3];
#pragma unroll
        for (int jj = 0; jj < 3; ++jj) {
            const int j = lane + 64 * jj; float d = -INFINITY;
            if (j <= 128) {
                const int idx = win + s - j * dil; d = 0.f;
                if (idx >= win) { const bf16_t* kp = QKV + (size_t)(MP + b * 4 + idx - win) * 4608 + 1536 + g * 512 + h * 128;
                    u32x4 kw[16];
#pragma unroll
                    for (int c = 0; c < 16; ++c) kw[c] = *(const u32x4*)(kp + c * 8);
#pragma unroll
                    for (int c = 0; c < 16; ++c) { const f32x4 qa = *(const LAS f32x4*)(ql + c * 8), qb_ = *(const LAS f32x4*)(ql + c * 8 + 4);
                        d += qa[0] * bflo(kw[c].x) + qa[1] * bfhi(kw[c].x) + qa[2] * bflo(kw[c].y) + qa[3] * bfhi(kw[c].y) + qb_[0] * bflo(kw[c].z) + qb_[1] * bfhi(kw[c].z) + qb_[2] * bflo(kw[c].w) + qb_[3] * bfhi(kw[c].w); } }
                else { const float* kp = cache + (size_t)idx * 1024;
#pragma unroll
                    for (int c0 = 0; c0 < 32; c0 += 16) { f32x4 kw[16];
#pragma unroll
                        for (int c = 0; c < 16; ++c) kw[c] = *(const f32x4*)(kp + (c0 + c) * 4);
#pragma unroll
                        for (int c = 0; c < 16; ++c) { const f32x4 qa = *(const LAS f32x4*)(ql + (c0 + c) * 4); d += qa[0] * kw[c][0] + qa[1] * kw[c][1] + qa[2] * kw[c][2] + qa[3] * kw[c][3]; } } }
                d = d * ATT_SC + C.a->in[7][BUCKET[g][j] * 12 + g * 4 + h] * LOG2E;
            }
            sc[jj] = d;
        }
        const float mx = wave_max(fmaxf(sc[0], fmaxf(sc[1], sc[2]))); float sum = 0.f;
#pragma unroll
        for (int jj = 0; jj < 3; ++jj) { const int j = lane + 64 * jj; if (j <= 128) { const float p = fexp2(sc[jj] - mx); sum += p; pl[j] = p; } }
        sum = wave_sum(sum);
        asm volatile("s_waitcnt lgkmcnt(0)" ::: "memory");
        float a0 = 0.f, a1 = 0.f;
        for (int j = 0; j < 4; ++j) {
            const float p = pl[j]; const int idx = win + s - j * dil;
            if (idx >= win) { const unsigned w = *(const unsigned*)(QKV + (size_t)(MP + b * 4 + idx - win) * 4608 + 3072 + g * 512 + h * 128 + 2 * lane); a0 += p * bflo(w); a1 += p * bfhi(w); }
            else { const f32x2v vv = *(const f32x2v*)(cache + (size_t)idx * 1024 + 512 + 2 * lane); a0 += p * vv[0]; a1 += p * vv[1]; }
        }
        const float* vbase = cache + (size_t)(win + s) * 1024 + 512 + 2 * lane;
        for (int j0 = 4; j0 <= 128; j0 += 25) {
            f32x2v vv[25];
#pragma unroll
            for (int k = 0; k < 25; ++k) vv[k] = *(const f32x2v*)(vbase - (size_t)(j0 + k) * dil * 1024);
#pragma unroll
            for (int k = 0; k < 25; ++k) { const float p = pl[j0 + k]; a0 += p * vv[k][0]; a1 += p * vv[k][1]; }
        }
        ol[2 + 2 * lane] = a0; ol[3 + 2 * lane] = a1; if (lane == 0) { ol[0] = mx; ol[1] = sum; }
    }
    __syncthreads();
    if (wave == 0 || wave == 3) {
        const LAS float* o0 = (const LAS float*)(C.lds + wave * 2048) + 264; const LAS float* o1 = o0 + 512; const LAS float* o2 = o0 + 1024;
        const float m0 = o0[0], m1 = o1[0], m2 = o2[0], M = fmaxf(m0, fmaxf(m1, m2)), w0 = fexp2(m0 - M), w1 = fexp2(m1 - M), w2 = fexp2(m2 - M);
        const float inv = 1.0f / (w0 * o0[1] + w1 * o1[1] + w2 * o2[1]);
        const float r0 = (w0 * o0[2 + 2 * lane] + w1 * o1[2 + 2 * lane] + w2 * o2[2 + 2 * lane]) * inv, r1 = (w0 * o0[3 + 2 * lane] + w1 * o1[3 + 2 * lane] + w2 * o2[3 + 2 * lane]) * inv;
        *(unsigned*)(WSP(bf16_t, WS_BR) + (size_t)(MP + b * 4 + s) * 512 + h * 128 + 2 * lane) = pk2(r0, r1);
    }
}
__device__ __forceinline__ void gmlp_unit(Ctx& C, int layer, int b, int n, int g) {
    const int tid = C.tid, lane = C.lane, wave = C.wave, q4 = lane >> 4;
    LAS unsigned char* A = C.lds; LAS unsigned char* VT = C.lds + TILE;
    const size_t row0 = (size_t)b * 2048 + 128 * n;
    __syncthreads();
    { const int t = tid >> 2, sq = (tid & 3) * 32; const float* wp = C.a->in[15] + ((size_t)(layer * 4 + g) * 128 + t) * 128 + sq;
#pragma unroll
      for (int k = 0; k < 4; ++k) { const f32x4 a = *(const f32x4*)(wp + 8 * k), bq = *(const f32x4*)(wp + 8 * k + 4); float x[8] = {a[0], a[1], a[2], a[3], bq[0], bq[1], bq[2], bq[3]};
#pragma unroll
          for (int e = 0; e < 8; ++e) if (sq + 8 * k + e > t) x[e] = 0.f;
          u32x4 w; w.x = pk2(x[0], x[1]); w.y = pk2(x[2], x[3]); w.z = pk2(x[4], x[5]); w.w = pk2(x[6], x[7]); *(LAS u32x4*)(A + t * TS_ + (sq + 8 * k) * 2) = w; } }
    { const int i = tid & 127, cq = tid >> 7; const u64* ssv = C.ssbase + (7 + layer) * MPAD; const float rstd = rsqrtf(ss_get(ssv + row0 + i) * (1.0f / 512) + EPS);
      const float* bv = WSP(float, WS_BV) + (row0 + i) * 512 + g * 128; const float* gg = C.a->in[14] + layer * 512 + g * 128;
#pragma unroll
      for (int it = 0; it < 8; ++it) { const int c0 = (cq + 4 * it) * 4; const f32x4 v = *(const f32x4*)(bv + c0), gv = *(const f32x4*)(gg + c0);
#pragma unroll
          for (int e = 0; e < 4; ++e) *(LAS bf16_t*)(VT + (c0 + e) * TS_ + i * 2) = f2bf(v[e] * rstd * gv[e]); } }
    __syncthreads();
    f32x4 acc[8];
#pragma unroll
    for (int nb = 0; nb < 8; ++nb) acc[nb] = (f32x4){0.f, 0.f, 0.f, 0.f};
    wave_gemm_nt<8, 4>(A + wave * 16 * TS_, VT, acc, lane);
    const int t = wave * 16 + (lane & 15); const float bs = C.a->in[16][(layer * 4 + g) * 128 + t]; const size_t row = row0 + t;
    const bf16_t* bu = WSP(bf16_t, WS_BU) + row * 512 + g * 128; bf16_t* br = WSP(bf16_t, WS_BR) + ((size_t)1 * MPAD + row) * 512 + g * 128;
#pragma unroll
    for (int nb = 0; nb < 8; ++nb) { const int c = nb * 16 + 4 * q4; const u32x2 uw = *(const u32x2*)(bu + c);
        u32x2 w; w.x = pk2(bflo(uw.x) * (acc[nb][0] + bs), bfhi(uw.x) * (acc[nb][1] + bs)); w.y = pk2(bflo(uw.y) * (acc[nb][2] + bs), bfhi(uw.y) * (acc[nb][3] + bs)); *(u32x2*)(br + c) = w; }
}
__device__ __forceinline__ void gmlp_sample_item(Ctx& C, int layer, int b) {
    const int c = C.tid, g = c >> 7; const u64* ssv = C.ssbase + (7 + layer) * MPAD; const float gg = C.a->in[14][layer * 512 + c];
    float vn[4];
#pragma unroll
    for (int t = 0; t < 4; ++t) { const size_t row = MP + b * 4 + t; vn[t] = WSP(float, WS_BV)[row * 512 + c] * rsqrtf(ss_get(ssv + row) * (1.0f / 512) + EPS) * gg;
        C.out[O_GVS + ((size_t)(layer * 32 + b) * 4 + t) * 512 + c] = vn[t]; }
#pragma unroll
    for (int t = 0; t < 4; ++t) { float mx = C.a->in[16][(layer * 4 + g) * 128 + t];
#pragma unroll
        for (int s = 0; s < 4; ++s) if (s <= t) mx += C.a->in[15][((size_t)(layer * 4 + g) * 128 + t) * 128 + s] * vn[s];
        const size_t row = MP + b * 4 + t; WSP(bf16_t, WS_BR)[((size_t)1 * MPAD + row) * 512 + c] = f2bf(bf2f(WSP(bf16_t, WS_BU)[row * 512 + c]) * mx); }
}
template <int NB, int KS>
__device__ __forceinline__ void wave_gemm_nt_bglobal(const LAS unsigned char* A, const bf16_t* BTg  , f32x4 (&acc)[NB], int lane) {
    const int r = lane & 15, q = lane >> 4;
#pragma unroll
    for (int ks = 0; ks < KS; ++ks) {
        const bf16x8 a = *(const LAS bf16x8*)(A + r * TS_ + ks * 64 + q * 16);
#pragma unroll
        for (int nb = 0; nb < NB; ++nb) { const bf16x8 b = *(const bf16x8*)(BTg + (nb * 16 + r) * (32 * KS) + ks * 32 + q * 8); acc[nb] = __builtin_amdgcn_mfma_f32_16x16x32_bf16(b, a, acc[nb], 0, 0, 0); }
    }
}
__device__ __forceinline__ void pool_unit(Ctx& C, int layer, int rb, int g) {
    const int tid = C.tid, lane = C.lane, wave = C.wave, q4 = lane >> 4, win = 2 << g;
    LAS float* EXT = (LAS float*)C.lds; LAS unsigned char* A = C.lds + 73728;
    const float* CIN = WSP(float, WS_CIN);
    __syncthreads();
    const int c = tid & 127, tq = tid >> 7, col = g * 128 + c;
    if (rb < 64) {
        const int bt0 = (rb & 15) * 128; const float* base = CIN + (size_t)(rb >> 4) * 2048 * 512 + g * 128;
#pragma unroll
        for (int k = 0; k < 9; ++k) { const int idx = tid + 512 * k, row = idx >> 5, ch = idx & 31;
            if (row < 143) { const int tt = bt0 - 15 + row; f32x4 v = (f32x4){0.f, 0.f, 0.f, 0.f}; if (tt >= 0) v = *(const f32x4*)(base + (size_t)tt * 512 + ch * 4); *(LAS f32x4*)(EXT + row * 128 + ch * 4) = v; } }
        __syncthreads();
        float wsum = 0.f;
        for (int i = 1; i < win; ++i) wsum += EXT[(15 + 32 * tq - i) * 128 + c];
#pragma unroll 4
        for (int k = 0; k < 32; ++k) { const int r = 32 * tq + k, t = bt0 + r; const float xv = EXT[(15 + r) * 128 + c]; wsum += xv; const int cnt = (t + 1) < win ? (t + 1) : win;
            *(LAS bf16_t*)(A + r * TS_ + c * 2) = f2bf(wsum / (float)cnt - xv); wsum -= EXT[(15 + r - win + 1) * 128 + c]; }
    } else {
        const float* sp = C.a->in[5];
        for (int bb = 0; bb < 8; ++bb) { const int b = 8 * tq + bb; const float* st = sp + (size_t)(layer * 32 + b) * 15 * 512 + col; const float* nw = CIN + (size_t)(MP + b * 4) * 512 + col;
            float e[19];
#pragma unroll
            for (int i = 0; i < 15; ++i) e[i] = st[(size_t)i * 512];
#pragma unroll
            for (int i = 0; i < 4; ++i) e[15 + i] = nw[(size_t)i * 512];
#pragma unroll
            for (int s = 0; s < 4; ++s) { float wsum = 0.f;
#pragma unroll
                for (int i = 0; i < 16; ++i) if (i < win) wsum += e[15 + s - i];
                *(LAS bf16_t*)(A + (b * 4 + s) * TS_ + c * 2) = f2bf(wsum / (float)win - e[15 + s]); }
#pragma unroll
            for (int i = 0; i < 11; ++i) C.out[O_POOLS + ((size_t)(layer * 32 + b) * 15 + i) * 512 + col] = e[i + 4]; }
    }
    __syncthreads();
    f32x4 acc[8];
#pragma unroll
    for (int nb = 0; nb < 8; ++nb) acc[nb] = (f32x4){0.f, 0.f, 0.f, 0.f};
    wave_gemm_nt_bglobal<8, 4>(A + wave * 16 * TS_, WSP(bf16_t, WS_WPT) + (size_t)(layer * 4 + g) * 16384, acc, lane);
    const size_t row = (size_t)rb * 128 + wave * 16 + (lane & 15); const float* ps = C.a->in[18] + layer * 512 + g * 128; bf16_t* br = WSP(bf16_t, WS_BR) + ((size_t)2 * MPAD + row) * 512 + g * 128;
#pragma unroll
    for (int nb = 0; nb < 8; ++nb) { const int d = nb * 16 + 4 * q4; const f32x4 sc = *(const f32x4*)(ps + d);
        u32x2 w; w.x = pk2(acc[nb][0] * sc[0], acc[nb][1] * sc[1]); w.y = pk2(acc[nb][2] * sc[2], acc[nb][3] * sc[3]); *(u32x2*)(br + d) = w; }
}
__device__ __forceinline__ void retloc_unit(Ctx& C, int b, int h, int c) {
    const int tid = C.tid, lane = C.lane, wave = C.wave, q4 = lane >> 4;
    LAS unsigned char* KT = C.lds; LAS unsigned char* VT = C.lds + TILE;
    const bf16_t* DR = WSP(bf16_t, WS_DR); const size_t row0 = (size_t)b * 2048 + 128 * c; const float lg = lg2gamma(h);
    __syncthreads();
    tile_load_T<true>(KT, DR + 512 + h * 128, row0, 1, 2048, tid, exp2f((float)(127 - (tid & 127)) * lg));
    tile_load_T<false>(VT, DR + 1024 + h * 128, row0, 1, 2048, tid, 1.f);
    __syncthreads();
    f32x4 acc[8];
#pragma unroll
    for (int nb = 0; nb < 8; ++nb) acc[nb] = (f32x4){0.f, 0.f, 0.f, 0.f};
    wave_gemm_nt<8, 4>(KT + wave * 16 * TS_, VT, acc, lane);
    float* loc = WSP(float, WS_LOC) + ((size_t)(b * 4 + h) * 16 + c) * 16384 + (wave * 16 + (lane & 15)) * 128;
#pragma unroll
    for (int nb = 0; nb < 8; ++nb) *(f32x4*)(loc + nb * 16 + 4 * q4) = acc[nb];
}
__device__ __forceinline__ void ret_sample_item(Ctx& C, int layer, int b, int h) {
    const int tid = C.tid, e = tid & 127, dq = tid >> 7;
    LAS float* qs = (LAS float*)C.lds; LAS float* ks = qs + 512; LAS float* vs = ks + 512; LAS float* qk = vs + 512; LAS float* red = qk + 16; LAS float* nrm = red + 2048;
    const bf16_t* DR = WSP(bf16_t, WS_DR); const float lg = lg2gamma(h);
    __syncthreads();
    for (int i = tid; i < 1536; i += 512) { const int which = i >> 9, t = (i >> 7) & 3, d = i & 127; qs[i] = bf2f(DR[(size_t)(MP + b * 4 + t) * 2048 + which * 512 + h * 128 + d]); }
    __syncthreads();
    if (tid < 16) { const int t = tid >> 2, s = tid & 3; float d = 0.f; for (int k = 0; k < 128; ++k) d += qs[t * 128 + k] * ks[s * 128 + k]; qk[tid] = d; }
    const float* S0 = C.a->in[6] + ((size_t)(layer * 32 + b) * 4 + h) * 16384; float* Sn = C.out + O_RETS + ((size_t)(layer * 32 + b) * 4 + h) * 16384;
    const float g1 = exp2f(lg), g2 = g1 * g1, g3 = g2 * g1, g4 = g2 * g2;
    float a0 = 0.f, a1 = 0.f, a2 = 0.f, a3 = 0.f; const float v0 = vs[e], v1 = vs[128 + e], v2 = vs[256 + e], v3 = vs[384 + e];
    for (int k0 = 0; k0 < 32; k0 += 16) { float sv[16];
#pragma unroll
        for (int k = 0; k < 16; ++k) sv[k] = S0[(32 * dq + k0 + k) * 128 + e];
#pragma unroll
        for (int k = 0; k < 16; ++k) { const int d = 32 * dq + k0 + k; const float s0 = sv[k];
            a0 += qs[d] * s0; a1 += qs[128 + d] * s0; a2 += qs[256 + d] * s0; a3 += qs[384 + d] * s0;
            Sn[d * 128 + e] = g4 * s0 + g3 * ks[d] * v0 + g2 * ks[128 + d] * v1 + g1 * ks[256 + d] * v2 + ks[384 + d] * v3; } }
    red[(dq * 4 + 0) * 128 + e] = a0; red[(dq * 4 + 1) * 128 + e] = a1; red[(dq * 4 + 2) * 128 + e] = a2; red[(dq * 4 + 3) * 128 + e] = a3;
    __syncthreads();
    const int t = dq; float o = (red[(0 * 4 + t) * 128 + e] + red[(1 * 4 + t) * 128 + e] + red[(2 * 4 + t) * 128 + e] + red[(3 * 4 + t) * 128 + e]) * exp2f((float)(t + 1) * lg);
    for (int s = 0; s <= t; ++s) o += exp2f((float)(t - s) * lg) * qk[t * 4 + s] * vs[s * 128 + e];
    const float sq = wave_sum(o * o); if (C.lane == 0) nrm[C.wave] = sq;
    __syncthreads();
    const float ms = (nrm[2 * t] + nrm[2 * t + 1]) * (1.0f / 128);
    const size_t row = MP + b * 4 + t;
    WSP(bf16_t, WS_BR)[((size_t)3 * MPAD + row) * 512 + h * 128 + e] = f2bf(o * rsqrtf(ms + EPS) * C.a->in[19][layer * 512 + h * 128 + e] * bf2f(DR[row * 2048 + 1536 + h * 128 + e]));
}
__device__ __forceinline__ void p_mix1(Ctx& C, int layer) {
    const int G = C.G, bid = C.bid;
    for (int it = bid; it < 768; it += G) { const int g = it >> 8, rem = it & 255, bh = rem >> 4, x = rem & 15; attn_unit(C, bh >> 2, g, bh & 3, g == 0 ? 0 : (g == 1 ? (x >> 2) : x), g == 0 ? x : (g == 1 ? (x & 3) : 0)); }
    for (int it = bid; it < 256; it += G) retloc_unit(C, it >> 6, (it >> 4) & 3, it & 15);
#if FUSE_MIX
    asm volatile("s_waitcnt vmcnt(0)" ::: "memory");
    __syncthreads();
    if (C.tid == 0) { __builtin_amdgcn_fence(__ATOMIC_RELEASE, "agent"); asm volatile("s_waitcnt vmcnt(0)" ::: "memory"); (void)xb_add((unsigned*)(C.ws + WS_CTL) + CW_WQ + 128 + layer * 16 + (bid >> 4), 1u); }
#endif
    for (int it = bid; it < 256; it += G) gmlp_unit(C, layer, it >> 6, (it >> 2) & 15, it & 3);
    for (int it = bid; it < 260; it += G) pool_unit(C, layer, it >> 2, it & 3);
    for (int it = bid; it < 256; it += G) { __syncthreads(); attn_sample_item(C, layer, it); }
    for (int it = (bid + G - 68 % G) % G; it < 32; it += G) { __syncthreads(); gmlp_sample_item(C, layer, it); }
    for (int it = (bid + G - 100 % G) % G; it < 128; it += G) ret_sample_item(C, layer, it >> 2, it & 3);
    __syncthreads();
}
__device__ __forceinline__ void retout_unit(Ctx& C, int layer, int b, int h, int c) {
    const int tid = C.tid, lane = C.lane, wave = C.wave, q4 = lane >> 4;
    LAS unsigned char* Ks = C.lds; LAS unsigned char* VT = C.lds + TILE; LAS unsigned char* ST = C.lds + 2 * TILE;
    const bf16_t* DR = WSP(bf16_t, WS_DR); const size_t row0 = (size_t)b * 2048 + 128 * c; const float lg = lg2gamma(h), cd = exp2f(128.0f * lg);
    __syncthreads();
    {
        typedef float f32x2_t __attribute__((ext_vector_type(2)));
        float* SB = WSP(float, WS_G); const int bh = b * 4 + h; const size_t sl = (size_t)bh * 16 * 16384 + c * 1024 + tid * 2;
        const float* loc = WSP(float, WS_LOC) + sl; float* sb = SB + sl;
        f32x2_t v[16];
#pragma unroll
        for (int j = 0; j < 16; ++j) v[j] = *(const f32x2_t*)(loc + (size_t)j * 16384);
        f32x2_t s = (f32x2_t){0.f, 0.f};
#pragma unroll
        for (int j = 0; j < 15; ++j) { s = s * cd + v[j]; *(f32x2_t*)(sb + (size_t)(j + 1) * 16384) = s; }
        s = s * cd + v[15];
        *(f32x2_t*)(C.out + O_RETP + ((size_t)(layer * 4 + b) * 4 + h) * 16384 + c * 1024 + tid * 2) = s;
        asm volatile("s_waitcnt vmcnt(0)" ::: "memory");
        __syncthreads();
        if (tid == 0) {
            unsigned* bar = (unsigned*)(C.ws + WS_CTL) + CW_BAR; unsigned* flag = (unsigned*)(C.ws + WS_CTL) + CW_WQ + 16 + layer * 16 + bh;
            __builtin_amdgcn_fence(__ATOMIC_RELEASE, "agent"); asm volatile("s_waitcnt vmcnt(0)" ::: "memory");
            (void)xb_add(flag, 1u);
            if (c > 0) XB_SPIN(xb_ld(flag) < 16u, bar);
            __builtin_amdgcn_fence(__ATOMIC_ACQUIRE, "agent"); asm volatile("s_waitcnt vmcnt(0)" ::: "memory");
        }
        __syncthreads();
        const int d = tid >> 2, e0 = (tid & 3) * 32; const float* sc = SB + ((size_t)bh * 16 + c) * 16384 + d * 128 + e0;
#pragma unroll
        for (int k8 = 0; k8 < 8; ++k8) { f32x4 w = (f32x4){0.f, 0.f, 0.f, 0.f}; if (c > 0) w = *(const f32x4*)(sc + 4 * k8);
#pragma unroll
            for (int e = 0; e < 4; ++e) *(LAS bf16_t*)(ST + (e0 + 4 * k8 + e) * TS_ + d * 2) = f2bf(w[e]); } }
    tile_load_nat(Ks, DR + 512 + h * 128, row0, 1, 2048, tid);
    tile_load_T<false>(VT, DR + 1024 + h * 128, row0, 1, 2048, tid, 1.f);
    const int t = wave * 16 + (lane & 15); const size_t row = row0 + t;
    bf16x8 qf[4];
#pragma unroll
    for (int ks = 0; ks < 4; ++ks) qf[ks] = *(const bf16x8*)(DR + row * 2048 + h * 128 + ks * 32 + q4 * 8);
    __syncthreads();
    f32x4 o[8], a[8];
#pragma unroll
    for (int nb = 0; nb < 8; ++nb) { o[nb] = (f32x4){0.f, 0.f, 0.f, 0.f}; a[nb] = (f32x4){0.f, 0.f, 0.f, 0.f}; }
    if (c > 0) { wave_gemm_nt_areg<8, 4>(qf, ST, o, lane); const float qd = exp2f((float)(t + 1) * lg);
#pragma unroll
        for (int nb = 0; nb < 8; ++nb) o[nb] *= qd; }
    wave_gemm_nt_areg<8, 4>(qf, Ks, a, lane);
#pragma unroll
    for (int nb = 0; nb < 8; ++nb)
#pragma unroll
        for (int i = 0; i < 4; ++i) { const int s = nb * 16 + 4 * q4 + i; a[nb][i] = (s <= t) ? a[nb][i] * exp2f((float)(t - s) * lg) : 0.f; }
    __syncthreads();
    store_p_rows(Ks + wave * 16 * TS_, a, lane);
    wave_gemm_nt<8, 4>(Ks + wave * 16 * TS_, VT, o, lane);
    float ms = 0.f;
#pragma unroll
    for (int nb = 0; nb < 8; ++nb) ms += (o[nb][0] * o[nb][0] + o[nb][1] * o[nb][1]) + (o[nb][2] * o[nb][2] + o[nb][3] * o[nb][3]);
    ms += __shfl_xor(ms, 16); ms += __shfl_xor(ms, 32);
    const float rn = rsqrtf(ms * (1.0f / 128) + EPS); const float* gr = C.a->in[19] + layer * 512 + h * 128; const bf16_t* dg = DR + row * 2048 + 1536 + h * 128;
    bf16_t* br = WSP(bf16_t, WS_BR) + ((size_t)3 * MPAD + row) * 512 + h * 128;
#pragma unroll
    for (int nb = 0; nb < 8; ++nb) { const int e = nb * 16 + 4 * q4; const f32x4 g4 = *(const f32x4*)(gr + e); const u32x2 gw = *(const u32x2*)(dg + e);
        u32x2 w; w.x = pk2(o[nb][0] * rn * g4[0] * bflo(gw.x), o[nb][1] * rn * g4[1] * bfhi(gw.x)); w.y = pk2(o[nb][2] * rn * g4[2] * bflo(gw.y), o[nb][3] * rn * g4[3] * bfhi(gw.y)); *(u32x2*)(br + e) = w; }
}
__device__ __forceinline__ void p_mix2(Ctx& C, int layer) {
#if FUSE_MIX
    if (C.tid == 0) { unsigned* bar = (unsigned*)(C.ws + WS_CTL) + CW_BAR; unsigned* fa = (unsigned*)(C.ws + WS_CTL) + CW_WQ + 128 + layer * 16 + (C.bid >> 4);
        XB_SPIN(xb_ld(fa) < 16u, bar); __builtin_amdgcn_fence(__ATOMIC_ACQUIRE, "agent"); asm volatile("s_waitcnt vmcnt(0)" ::: "memory"); }
    __syncthreads();
#endif
    for (int it = C.bid; it < 256; it += C.G) retout_unit(C, layer, it >> 6, (it >> 4) & 3, it & 15);
    const bf16_t* AO = WSP(bf16_t, WS_AO); const float* LSE = WSP(float, WS_LSE); bf16_t* br = WSP(bf16_t, WS_BR);
#if FUSE_MIX
    for (int k = 0; k < 4; ++k) {
        const int il = (C.bid & 15) * 2048 + k * 512 + C.tid, bh = C.bid >> 4;
        const int row = (bh >> 2) * 2048 + (il >> 4), h = bh & 3, ch = il & 15;
#else
    unsigned* wq = (unsigned*)(C.ws + WS_CTL) + CW_WQ + layer; volatile LAS unsigned* slot = (volatile LAS unsigned*)(C.lds + MISC_OFF) + 12;
    for (;;) {
        __syncthreads();
        if (C.tid == 0) *slot = __hip_atomic_fetch_add(wq, 1u, __ATOMIC_RELAXED, __HIP_MEMORY_SCOPE_AGENT);
        __syncthreads();
        const unsigned chunk = *slot; if (chunk >= (unsigned)(MP * 64 / 512)) break;
        const int idx = (int)chunk * 512 + C.tid;
        const int row = idx >> 6, h = (idx >> 4) & 3, ch = idx & 15;
#endif
        const float l0 = LSE[((size_t)0 * MPAD + row) * 4 + h], l1 = LSE[((size_t)1 * MPAD + row) * 4 + h], l2 = LSE[((size_t)2 * MPAD + row) * 4 + h];
        const float mx = fmaxf(l0, fmaxf(l1, l2)); float w0 = fexp2(l0 - mx), w1 = fexp2(l1 - mx), w2 = fexp2(l2 - mx); const float inv = 1.0f / (w0 + w1 + w2); w0 *= inv; w1 *= inv; w2 *= inv;
        const size_t off = (size_t)row * 512 + h * 128 + ch * 8;
        const u32x4 a = *(const u32x4*)(AO + off), bq = *(const u32x4*)(AO + (size_t)MPAD * 512 + off), cq = *(const u32x4*)(AO + (size_t)2 * MPAD * 512 + off);
        u32x4 w;
        w.x = pk2(w0 * bflo(a.x) + w1 * bflo(bq.x) + w2 * bflo(cq.x), w0 * bfhi(a.x) + w1 * bfhi(bq.x) + w2 * bfhi(cq.x));
        w.y = pk2(w0 * bflo(a.y) + w1 * bflo(bq.y) + w2 * bflo(cq.y), w0 * bfhi(a.y) + w1 * bfhi(bq.y) + w2 * bfhi(cq.y));
        w.z = pk2(w0 * bflo(a.z) + w1 * bflo(bq.z) + w2 * bflo(cq.z), w0 * bfhi(a.z) + w1 * bfhi(bq.z) + w2 * bfhi(cq.z));
        w.w = pk2(w0 * bflo(a.w) + w1 * bflo(bq.w) + w2 * bflo(cq.w), w0 * bfhi(a.w) + w1 * bfhi(bq.w) + w2 * bfhi(cq.w));
        *(u32x4*)(br + off) = w;
    }
    __syncthreads();
}
__device__ __forceinline__ void p_final(Ctx& C) {
    const float* X = WSP(float, WS_X); const float* gf = C.a->in[26];
    for (int row = C.bid * 8 + C.wave; row < MR; row += C.G * 8) {
        f32x4 v[8]; float s = 0.f;
#pragma unroll
        for (int j = 0; j < 8; ++j) { v[j] = *(const f32x4*)(X + (size_t)row * DM + j * 256 + C.lane * 4); s += (v[j][0] * v[j][0] + v[j][1] * v[j][1]) + (v[j][2] * v[j][2] + v[j][3] * v[j][3]); }
        const float r = rsqrtf(wave_sum(s) * (1.0f / DM) + EPS);
#pragma unroll
        for (int j = 0; j < 8; ++j) { const int c = j * 256 + C.lane * 4; const f32x4 g = *(const f32x4*)(gf + c); *(f32x4*)(C.out + (size_t)row * DM + c) = v[j] * r * g; }
    }
}

__device__ __forceinline__ void ctx_init(Ctx& C, KArgs a, LAS unsigned char* lds) {
    C.lds = lds; C.tid = threadIdx.x; C.lane = C.tid & 63; C.wave = __builtin_amdgcn_readfirstlane(C.tid >> 6); C.G = gridDim.x; C.bid = blockIdx.x;
    C.a = a; C.out = a->out; C.ws = a->ws; C.ssbase = (u64*)((float*)(a->ws + WS_CTL) + CW_SS);
}
__device__ __forceinline__ f32x4 wave_gemm_global(const bf16_t* ap, const bf16_t* bp, int K) {
    f32x4 acc = (f32x4){0.f, 0.f, 0.f, 0.f};
    bf16x8 a0[8], b0[8], a1[8], b1[8];
#pragma unroll
    for (int j = 0; j < 8; ++j) { a0[j] = *(const bf16x8*)(ap + 32 * j); b0[j] = *(const bf16x8*)(bp + 32 * j); }
#pragma unroll 1
    for (int k = 0;; k += 512) {
        if (k + 256 < K) {
#pragma unroll
            for (int j = 0; j < 8; ++j) { a1[j] = *(const bf16x8*)(ap + k + 256 + 32 * j); b1[j] = *(const bf16x8*)(bp + k + 256 + 32 * j); } }
#pragma unroll
        for (int j = 0; j < 8; ++j) acc = __builtin_amdgcn_mfma_f32_16x16x32_bf16(b0[j], a0[j], acc, 0, 0, 0);
        if (k + 256 >= K) break;
        if (k + 512 < K) {
#pragma unroll
            for (int j = 0; j < 8; ++j) { a0[j] = *(const bf16x8*)(ap + k + 512 + 32 * j); b0[j] = *(const bf16x8*)(bp + k + 512 + 32 * j); } }
#pragma unroll
        for (int j = 0; j < 8; ++j) acc = __builtin_amdgcn_mfma_f32_16x16x32_bf16(b1[j], a1[j], acc, 0, 0, 0);
        if (k + 512 >= K) break;
    }
    return acc;
}
__device__ __forceinline__ void sample_res_gemm(Ctx& C, const bf16_t* A, int K, const bf16_t* Bt, u64* ssn, float alpha, int pm, int pn) {
    const int lane = C.lane, q4 = lane >> 4, cb = pn * 16 + (pm >> 1), rb = 4 * (pm & 1) + (C.wave >> 1), kh = C.wave & 1, Kh = K >> 1;
    const bf16_t* ap = A + (size_t)(MP + rb * 16 + (lane & 15)) * K + kh * Kh + q4 * 8; const bf16_t* bp = Bt + (size_t)(cb * 16 + (lane & 15)) * K + kh * Kh + q4 * 8;
    f32x4 acc = wave_gemm_global(ap, bp, Kh);
    LAS f32x4* red = (LAS f32x4*)C.lds + (C.wave >> 1) * 64 + lane;
    __syncthreads(); if (kh) *red = acc; __syncthreads();
    if (!kh) { acc += *red;
        const int row = MP + rb * 16 + (lane & 15), col = cb * 16 + 4 * q4;
        float* xp = WSP(float, WS_X) + (size_t)row * DM + col; f32x4 x = *(const f32x4*)xp; x += acc * alpha; *(f32x4*)xp = x;
        u32x2 w; w.x = pk2(x[0], x[1]); w.y = pk2(x[2], x[3]); *(u32x2*)(WSP(bf16_t, WS_XB) + (size_t)row * DM + col) = w;
        *(unsigned*)(WSP(unsigned char, WS_XB8) + (size_t)row * DM + col) = pk4_fp8(x[0] * X8_SCALE, x[1] * X8_SCALE, x[2] * X8_SCALE, x[3] * X8_SCALE);
        float s = (x[0] * x[0] + x[1] * x[1]) + (x[2] * x[2] + x[3] * x[3]); s += __shfl_xor(s, 16); s += __shfl_xor(s, 32);
        if (q4 == 0) ss_add(ssn + row, s); }
}
__device__ __forceinline__ f32x4 wave_gemm_global8(const unsigned char* ap, const unsigned char* bp, int Kb) {
    f32x4 acc = (f32x4){0.f, 0.f, 0.f, 0.f};
    bf16x8 a0[4], b0[4], a1[4], b1[4];
#pragma unroll
    for (int j = 0; j < 4; ++j) { a0[j] = *(const bf16x8*)(ap + 64 * j); b0[j] = *(const bf16x8*)(bp + 64 * j); }
#pragma unroll 1
    for (int k = 0;; k += 512) {
        if (k + 256 < Kb) {
#pragma unroll
            for (int j = 0; j < 4; ++j) { a1[j] = *(const bf16x8*)(ap + k + 256 + 64 * j); b1[j] = *(const bf16x8*)(bp + k + 256 + 64 * j); } }
        acc = pg8::mma8(b0[0], b0[1], a0[0], a0[1], acc); acc = pg8::mma8(b0[2], b0[3], a0[2], a0[3], acc);
        if (k + 256 >= Kb) break;
        if (k + 512 < Kb) {
#pragma unroll
            for (int j = 0; j < 4; ++j) { a0[j] = *(const bf16x8*)(ap + k + 512 + 64 * j); b0[j] = *(const bf16x8*)(bp + k + 512 + 64 * j); } }
        acc = pg8::mma8(b1[0], b1[1], a1[0], a1[1], acc); acc = pg8::mma8(b1[2], b1[3], a1[2], a1[3], acc);
        if (k + 512 >= Kb) break;
    }
    return acc;
}
template <int NB2>
__device__ __forceinline__ f32x4 wave_gemm_global8p(const unsigned char* ap, const unsigned char* bp) {
    f32x4 acc = (f32x4){0.f, 0.f, 0.f, 0.f};
    bf16x8 a[4][4], b[4][4];
#pragma unroll
    for (int s = 0; s < 3 && s < NB2; ++s)
#pragma unroll
        for (int j = 0; j < 4; ++j) { a[s][j] = *(const bf16x8*)(ap + 256 * s + 64 * j); b[s][j] = *(const bf16x8*)(bp + 256 * s + 64 * j); }
#pragma unroll
    for (int i = 0; i < NB2; ++i) {
        if (i + 3 < NB2) {
#pragma unroll
            for (int j = 0; j < 4; ++j) { a[(i + 3) & 3][j] = *(const bf16x8*)(ap + 256 * (i + 3) + 64 * j); b[(i + 3) & 3][j] = *(const bf16x8*)(bp + 256 * (i + 3) + 64 * j); } }
        acc = pg8::mma8(b[i & 3][0], b[i & 3][1], a[i & 3][0], a[i & 3][1], acc); acc = pg8::mma8(b[i & 3][2], b[i & 3][3], a[i & 3][2], a[i & 3][3], acc);
    }
    return acc;
}
__device__ __forceinline__ void sample_res_gemm8(Ctx& C, const unsigned char* A8, int Kb, const unsigned char* Bt8, u64* ssn, float alpha, int pm, int pn) {
    const int lane = C.lane, q4 = lane >> 4, cb = pn * 16 + (pm >> 1), rb = 4 * (pm & 1) + (C.wave >> 1), kh = C.wave & 1, Kh = Kb >> 1;
    const unsigned char* ap = A8 + (size_t)(MP + rb * 16 + (lane & 15)) * Kb + kh * Kh + q4 * 16; const unsigned char* bp = Bt8 + (size_t)(cb * 16 + (lane & 15)) * Kb + kh * Kh + q4 * 16;
    f32x4 acc = (Kh == 2816) ? wave_gemm_global8p<11>(ap, bp) : wave_gemm_global8(ap, bp, Kh);
    LAS f32x4* red = (LAS f32x4*)C.lds + (C.wave >> 1) * 64 + lane;
    __syncthreads(); if (kh) *red = acc; __syncthreads();
    if (!kh) { acc += *red;
        const int row = MP + rb * 16 + (lane & 15), col = cb * 16 + 4 * q4;
        float* xp = WSP(float, WS_X) + (size_t)row * DM + col; f32x4 x = *(const f32x4*)xp; x += acc * alpha; *(f32x4*)xp = x;
        u32x2 w; w.x = pk2(x[0], x[1]); w.y = pk2(x[2], x[3]); *(u32x2*)(WSP(bf16_t, WS_XB) + (size_t)row * DM + col) = w;
        *(unsigned*)(WSP(unsigned char, WS_XB8) + (size_t)row * DM + col) = pk4_fp8(x[0] * X8_SCALE, x[1] * X8_SCALE, x[2] * X8_SCALE, x[3] * X8_SCALE);
        float s = (x[0] * x[0] + x[1] * x[1]) + (x[2] * x[2] + x[3] * x[3]); s += __shfl_xor(s, 16); s += __shfl_xor(s, 32);
        if (q4 == 0) ss_add(ssn + row, s); }
}
__device__ __forceinline__ void sample_merge_gemm(Ctx& C, const bf16_t* WB  , int pm, int pn) {
    const int lane = C.lane, q4 = lane >> 4, cb = pn * 16 + (pm >> 1), rb = 4 * (pm & 1) + (C.wave >> 1), kh = C.wave & 1;
    const int row = MP + rb * 16 + (lane & 15), col = cb * 16 + 4 * q4; f32x4 m = (f32x4){0.f, 0.f, 0.f, 0.f};
#pragma unroll 1
    for (int n = 0; n < 4; ++n) {
        const f32x4 acc = wave_gemm_global(WSP(bf16_t, WS_BR) + ((size_t)n * MPAD + MP + rb * 16 + (lane & 15)) * 512 + kh * 256 + q4 * 8, WB + ((size_t)n * DM + cb * 16 + (lane & 15)) * 512 + kh * 256 + q4 * 8, 256);
        const u32x2 gw = *(const u32x2*)(WSP(bf16_t, WS_GATE) + (size_t)row * 8192 + n * 2048 + col);
        m[0] = (m[0] + acc[0]) * bflo(gw.x); m[1] = (m[1] + acc[1]) * bfhi(gw.x); m[2] = (m[2] + acc[2]) * bflo(gw.y); m[3] = (m[3] + acc[3]) * bfhi(gw.y);
    }
    LAS f32x4* red = (LAS f32x4*)C.lds + (C.wave >> 1) * 64 + lane;
    __syncthreads(); if (kh) *red = m; __syncthreads();
    if (!kh) { m += *red; u32x2 w; w.x = pk2(m[0], m[1]); w.y = pk2(m[2], m[3]); *(u32x2*)(WSP(bf16_t, WS_MG) + (size_t)row * DM + col) = w; }
}
struct GateOrder {
    pg8::StaticOrder P; int c;
    __device__ void init(int c_) { P.init(MPAD, INW / 2, 1, 0); c = c_; }
    __device__ bool next(int i, pg8::Unit& u) const {
        int L;
        if (i < 3) L = i * 256 + c; else if (i == 3) { if (c < 32) return false; L = 768 + (c - 32); } else if (i == 4) { if (c < 32 || c >= 96) return false; L = 992 + (c - 32); } else return false;
        pg8::StaticOrder Q = P; Q.c = L; return Q.next(0, u);
    }
    __device__ __forceinline__ void a_ready(const pg8::Unit&) const {}
    __device__ __forceinline__ void done(const pg8::Unit&) const {}
};
__device__ __forceinline__ void ph_up(Ctx& C, int l, int f) {
    unsigned char* wl = C.ws + WS_W + (size_t)l * W_LAYER;
    pg8::Gemm g{WSP(bf16_t, WS_XB), (const bf16_t*)(wl + (f ? WL_GU2 : WL_GU1)), MPAD, 2 * DFF, DM}; pg8::StaticOrder S; S.init(MPAD, 2 * DFF, C.G, C.bid);
    EpiGU E{WSP(bf16_t, WS_G), C.ssbase + (3 * l + 2 * f) * MPAD, ((D8_MASK >> (2 * l + f)) & 1) ? WSP(unsigned char, WS_G8) : nullptr};
    pg8::gemm_phase<EpiGU, pg8::StaticOrder, GP_ALIGN, GP_SP2, false, SKIP_PM>(C.lds, g, S, E);
}
__device__ __forceinline__ void ph_down(Ctx& C, int l, int f) {
    unsigned char* wl = C.ws + WS_W + (size_t)l * W_LAYER;
    pg8::Gemm g{WSP(bf16_t, WS_G), (const bf16_t*)(wl + (f ? WL_D2 : WL_D1)), MP, DM, DFF}; pg8::StaticOrder S; S.init(MP, DM, C.G, C.bid);
    const bool fin = FUSE_FINAL && l == 1 && f == 1;
    unsigned* bar = (unsigned*)(C.ws + WS_CTL) + CW_BAR; unsigned* cnt = (unsigned*)(C.ws + WS_CTL) + CW_WQ + 64;
    pg8::Unit u0; const bool has = S.next(0, u0);
    if (has) {
        if ((D8_MASK >> (2 * l + f)) & 1) sample_res_gemm8(C, C.ws + WS_G8, DFF, C.ws + WS_WD8 + (size_t)(2 * l + f) * (12u << 20), C.ssbase + (3 * l + 2 * f + 1) * MPAD, 0.5f / (X8_SCALE * W8_SCALE), u0.pm, u0.pn);
        else sample_res_gemm(C, WSP(bf16_t, WS_G), DFF, (const bf16_t*)(wl + (f ? WL_D2 : WL_D1)), C.ssbase + (3 * l + 2 * f + 1) * MPAD, 0.5f, u0.pm, u0.pn);
    }
    if (fin) { asm volatile("s_waitcnt vmcnt(0)" ::: "memory"); __syncthreads();
        if (C.tid == 0) { __builtin_amdgcn_fence(__ATOMIC_RELEASE, "agent"); asm volatile("s_waitcnt vmcnt(0)" ::: "memory"); (void)xb_add(cnt + 32, 1u); } }
    __syncthreads();
    const bool f8 = (D8_MASK >> (2 * l + f)) & 1;
    pg8::Gemm g8{(const bf16_t*)(C.ws + WS_G8), (const bf16_t*)(C.ws + WS_WD8 + (size_t)(2 * l + f) * (12u << 20)), MP, DM, DFF / 2};
    const float alpha = f8 ? 0.5f / (X8_SCALE * W8_SCALE) : 0.5f;
    if (fin) {
        EpiResFinal E{WSP(bf16_t, WS_XB), C.ssbase + (3 * l + 2 * f + 1) * MPAD, C.a->in[26], C.out, cnt, bar, alpha};
        if (f8) pg8::gemm_phase<EpiResFinal, pg8::StaticOrder, GP_ALIGN, GP_SP2, true>(C.lds, g8, S, E);
        else pg8::gemm_phase<EpiResFinal, pg8::StaticOrder, GP_ALIGN, GP_SP2>(C.lds, g, S, E);
        if (has && u0.pn == 0) {
            if (C.tid == 0) { XB_SPIN(xb_ld(cnt + 32) < (unsigned)C.G, bar); __builtin_amdgcn_fence(__ATOMIC_ACQUIRE, "agent"); asm volatile("s_waitcnt vmcnt(0)" ::: "memory"); }
            __syncthreads();
            if (C.wave < 4) { const int row = MP + u0.pm * 4 + C.wave; const float* X = WSP(float, WS_X); const float* gf = C.a->in[26];
                f32x4 v[8]; float s = 0.f;
#pragma unroll
                for (int j = 0; j < 8; ++j) { v[j] = *(const f32x4*)(X + (size_t)row * DM + j * 256 + C.lane * 4); s += (v[j][0] * v[j][0] + v[j][1] * v[j][1]) + (v[j][2] * v[j][2] + v[j][3] * v[j][3]); }
                const float r = rsqrtf(wave_sum(s) * (1.0f / DM) + EPS);
#pragma unroll
                for (int j = 0; j < 8; ++j) { const int c = j * 256 + C.lane * 4; const f32x4 gg = *(const f32x4*)(gf + c); *(f32x4*)(C.out + (size_t)row * DM + c) = v[j] * r * gg; } }
        }
    } else {
        EpiRes E{WSP(float, WS_X), WSP(bf16_t, WS_XB), C.ssbase + (3 * l + 2 * f + 1) * MPAD, f == 0 ? WSP(unsigned char, WS_XB8) : nullptr, alpha};
        if (f8) pg8::gemm_phase<EpiRes, pg8::StaticOrder, GP_ALIGN, GP_SP2, true>(C.lds, g8, S, E);
        else pg8::gemm_phase<EpiRes, pg8::StaticOrder, GP_ALIGN, GP_SP2>(C.lds, g, S, E);
    }
}
__device__ __forceinline__ void ph_win(Ctx& C, int l) {
    unsigned char* wl = C.ws + WS_W + (size_t)l * W_LAYER;
    pg8::Gemm g{WSP(bf16_t, WS_XB), (const bf16_t*)(wl + WL_IN) + (size_t)1536 * DM, MPAD, 6656, DM}; pg8::StaticOrder S; S.init(MPAD, 6656, C.G, C.bid);
    EpiIn E{C.ssbase + (3 * l + 1) * MPAD, WSP(bf16_t, WS_QKV), WSP(bf16_t, WS_BU), WSP(float, WS_BV), WSP(float, WS_CIN), WSP(bf16_t, WS_DR), WSP(bf16_t, WS_GATE),
            C.ssbase + (7 + l) * MPAD, WSP(float, WS_ROT), C.out, l, 6};
    pg8::gemm_phase<EpiIn, pg8::StaticOrder, GP_ALIGN, GP_SP2, false, SKIP_PM>(C.lds, g, S, E);
    pg8::Gemm g8{(const bf16_t*)(C.ws + WS_XB8), (const bf16_t*)(wl + WL_IN + W8_OFF), MPAD, 9728, DM / 2}; pg8::StaticOrder S8; S8.init(MPAD, 9728, C.G, C.bid);
    EpiGate E8{C.ssbase + (3 * l + 1) * MPAD, WSP(bf16_t, WS_GATE), WSP(bf16_t, WS_QKV)};
    pg8::gemm_phase<EpiGate, pg8::StaticOrder, GP_ALIGN, GP_SP2, true, SKIP_PM>(C.lds, g8, S8, E8);
}
struct MergeOrder {
    pg8::StaticOrder P;
    __device__ void init(int G, int c) { P.init(MP, DM, G, c); }
    __device__ bool next(int i, pg8::Unit& u) const { if (i >= 4 || !P.next(0, u)) return false; u.pm += (MPAD / 256) * i; u.pn += 8 * i; return true; }
    __device__ __forceinline__ void a_ready(const pg8::Unit&) const {}
    __device__ __forceinline__ void done(const pg8::Unit&) const {}
};
__device__ __forceinline__ void ph_merge(Ctx& C, int l) {
    unsigned char* wl = C.ws + WS_W + (size_t)l * W_LAYER;
    { pg8::StaticOrder S; S.init(MP, DM, C.G, C.bid); pg8::Unit u; if (S.next(0, u)) sample_merge_gemm(C, (const bf16_t*)(wl + WL_B), u.pm, u.pn); }
    __syncthreads();
    pg8::Gemm g{WSP(bf16_t, WS_BR), (const bf16_t*)(wl + WL_B), MP, DM, 512}; MergeOrder S; S.init(C.G, C.bid);
    EpiMerge E{WSP(bf16_t, WS_GATE), WSP(bf16_t, WS_MG), l};
    pg8::gemm_phase<EpiMerge, MergeOrder, GP_ALIGN, GP_SP2>(C.lds, g, S, E);
}
__device__ __forceinline__ void ph_wo(Ctx& C, int l) {
    unsigned char* wl = C.ws + WS_W + (size_t)l * W_LAYER;
    pg8::Gemm g{WSP(bf16_t, WS_MG), (const bf16_t*)(wl + WL_O), MP, DM, DM}; pg8::StaticOrder S; S.init(MP, DM, C.G, C.bid);
    EpiRes E{WSP(float, WS_X), WSP(bf16_t, WS_XB), C.ssbase + (3 * l + 2) * MPAD, nullptr, 1.0f};
    { pg8::Unit u; if (S.next(0, u)) sample_res_gemm(C, WSP(bf16_t, WS_MG), DM, (const bf16_t*)(wl + WL_O), C.ssbase + (3 * l + 2) * MPAD, 1.0f, u.pm, u.pn); }
    __syncthreads();
    pg8::gemm_phase<EpiRes, pg8::StaticOrder, GP_ALIGN, GP_SP2>(C.lds, g, S, E);
}
__global__ void __launch_bounds__(512, 2) fwd(Args args) {
    extern __shared__ __attribute__((aligned(16))) unsigned char lds_raw[];
    Ctx C; ctx_init(C, (KArgs)__builtin_amdgcn_kernarg_segment_ptr(), (LAS unsigned char*)lds_raw);
    volatile LAS unsigned* MISC = (volatile LAS unsigned*)(C.lds + MISC_OFF);
    for (int u = C.tid; u < (LDS_BYTES - RING_BYTES) / 4; u += 512) ((LAS unsigned*)(C.lds + RING_BYTES))[u] = 0u;
    __syncthreads();
#if ONE_LAUNCH
    XcdBarrier bar = xcd_barrier_post((unsigned*)(C.ws + WS_CTL) + CW_BAR, MISC + 8);
#define GRID_BAR() xcd_barrier(bar)
#else
    (void)MISC;
#define GRID_BAR() do { } while (0)
#endif
    const int lo = C.a->ph_lo, hi = C.a->ph_hi;
#define IN(k) (lo <= (k) && (k) < hi)
#define SEAM(k) do { if (IN(k) && IN((k) + 1)) GRID_BAR(); } while (0)
#define LAYER(l, pb) \
    if ((PH_MASK & 2) && IN(pb)) { ph_up(C, l, 0); SEAM(pb); } \
    if ((PH_MASK & 4) && IN(pb + 1)) { ph_down(C, l, 0); SEAM(pb + 1); } \
    if ((PH_MASK & 8) && IN(pb + 2)) { ph_win(C, l); SEAM(pb + 2); } \
    if ((PH_MASK & 16) && IN(pb + 3)) { p_mix1(C, l); if (!FUSE_MIX) SEAM(pb + 3); } \
    if ((PH_MASK & 32) && IN(pb + 4)) { p_mix2(C, l); SEAM(pb + 4); } \
    if ((PH_MASK & 64) && IN(pb + 5)) { ph_merge(C, l); SEAM(pb + 5); } \
    if ((PH_MASK & 128) && IN(pb + 6)) { ph_wo(C, l); SEAM(pb + 6); } \
    if ((PH_MASK & 2) && IN(pb + 7)) { ph_up(C, l, 1); SEAM(pb + 7); } \
    if ((PH_MASK & 4) && IN(pb + 8)) { ph_down(C, l, 1); if (!(FUSE_FINAL && (l) == 1)) SEAM(pb + 8); }
    if ((PH_MASK & 1) && IN(0)) { p_prologue(C); SEAM(0); }
    LAYER(0, 1)
    LAYER(1, 10)
    if (!FUSE_FINAL && (PH_MASK & 256) && IN(19)) p_final(C);
#undef IN
#undef SEAM
}

#ifdef ZMASK
__global__ void dbg_zero(float* dst, size_t n) { for (size_t i = (size_t)blockIdx.x * blockDim.x + threadIdx.x; i < n; i += (size_t)gridDim.x * blockDim.x) dst[i] = 0.f; }
#endif

#ifdef SELFCHK
constexpr size_t WS_REF = 1076ull << 20, WS_DIFF = 1096ull << 20;
__device__ __forceinline__ bool chk_row(int row) { return row < 2048 || row >= MP; }
__global__ void nv_gmlp(Args a, int l) {
    const unsigned char* ws = a.ws; const float* BV = (const float*)(ws + WS_BV); const bf16_t* BU = (const bf16_t*)(ws + WS_BU); const float* ssv = (const float*)(ws + WS_CTL) + CW_SS + (7 + l) * MPAD; float* REF = (float*)(ws + WS_REF);
    for (size_t i = (size_t)blockIdx.x * blockDim.x + threadIdx.x; i < (size_t)MR * 512; i += (size_t)gridDim.x * blockDim.x) {
        const int row = (int)(i >> 9), c = (int)(i & 511), g = c >> 7; if (!chk_row(row)) continue;
        const int tc = row < MP ? (row & 127) : ((row - MP) & 3), row0 = row - tc;
        float mx = a.in[16][(l * 4 + g) * 128 + tc];
        for (int s = 0; s <= tc; ++s) { const int r = row0 + s; const float vn = BV[(size_t)r * 512 + c] * rsqrtf(ssv[r] * (1.0f / 512) + EPS) * a.in[14][l * 512 + c]; mx += a.in[15][((size_t)(l * 4 + g) * 128 + tc) * 128 + s] * vn; }
        REF[(size_t)row * 512 + c] = bf2f(BU[(size_t)row * 512 + c]) * mx;
    }
}
__global__ void nv_pool_diff(Args a, int l) {
    const unsigned char* ws = a.ws; const float* CIN = (const float*)(ws + WS_CIN); float* DIFF = (float*)(ws + WS_DIFF);
    for (size_t i = (size_t)blockIdx.x * blockDim.x + threadIdx.x; i < (size_t)MR * 512; i += (size_t)gridDim.x * blockDim.x) {
        const int row = (int)(i >> 9), col = (int)(i & 511), g = col >> 7, win = 2 << g; if (!chk_row(row)) continue;
        float wsum = 0.f, cnt;
        if (row < MP) { const int t = row & 2047; for (int k = 0; k < win; ++k) if (t - k >= 0) wsum += CIN[(size_t)(row - k) * 512 + col]; cnt = (float)((t + 1) < win ? (t + 1) : win); }
        else { const int rs = row - MP, b = rs >> 2, s = rs & 3; for (int k = 0; k < win; ++k) { const int idx = 15 + s - k; wsum += idx < 15 ? a.in[5][((size_t)(l * 32 + b) * 15 + idx) * 512 + col] : CIN[(size_t)(MP + b * 4 + idx - 15) * 512 + col]; } cnt = (float)win; }
        DIFF[(size_t)row * 512 + col] = wsum / cnt - CIN[(size_t)row * 512 + col];
    }
}
__global__ void nv_pool_mm(Args a, int l) {
    const unsigned char* ws = a.ws; const float* DIFF = (const float*)(ws + WS_DIFF); float* REF = (float*)(ws + WS_REF);
    for (size_t i = (size_t)blockIdx.x * blockDim.x + threadIdx.x; i < (size_t)MR * 512; i += (size_t)gridDim.x * blockDim.x) {
        const int row = (int)(i >> 9), dd = (int)(i & 511), g = dd >> 7, d = dd & 127; if (!chk_row(row)) continue;
        float y = 0.f; for (int c = 0; c < 128; ++c) y += DIFF[(size_t)row * 512 + g * 128 + c] * a.in[17][((size_t)(l * 4 + g) * 128 + c) * 128 + d];
        REF[(size_t)row * 512 + dd] = y * a.in[18][l * 512 + dd];
    }
}
__global__ void nv_ret(Args a, int l) {
    __shared__ float dots[128]; __shared__ float red[128]; __shared__ float qsh[128];
    const unsigned char* ws = a.ws; const bf16_t* DR = (const bf16_t*)(ws + WS_DR); float* REF = (float*)(ws + WS_REF);
    const int e = threadIdx.x;
    for (int item = blockIdx.x; item < (2048 + 128) * 4; item += gridDim.x) {
        const int h = item & 3, rr = item >> 2, row = rr < 2048 ? rr : MP + (rr - 2048);
        const float lg = lg2gamma(h); float o = 0.f;
        __syncthreads(); qsh[e] = bf2f(DR[(size_t)row * 2048 + h * 128 + e]); __syncthreads();
        if (row < MP) { const int t = row;
            for (int s0 = 0; s0 <= t; s0 += 128) {
                const int s = s0 + e; float d = 0.f;
                if (s <= t) { for (int k = 0; k < 128; ++k) d += qsh[k] * bf2f(DR[(size_t)s * 2048 + 512 + h * 128 + k]); d *= exp2f((float)(t - s) * lg); }
                __syncthreads(); dots[e] = d; __syncthreads();
                const int ns = (t - s0 + 1) < 128 ? (t - s0 + 1) : 128;
                for (int i = 0; i < ns; ++i) o += dots[i] * bf2f(DR[(size_t)(s0 + i) * 2048 + 1024 + h * 128 + e]);
            }
        } else { const int rs = row - MP, b = rs >> 2, t = rs & 3; const float* S0 = a.in[6] + ((size_t)(l * 32 + b) * 4 + h) * 16384;
            float st = 0.f; for (int d = 0; d < 128; ++d) st += qsh[d] * S0[d * 128 + e]; o = st * exp2f((float)(t + 1) * lg);
            for (int s = 0; s <= t; ++s) { float d = 0.f; for (int k = 0; k < 128; ++k) d += qsh[k] * bf2f(DR[(size_t)(MP + b * 4 + s) * 2048 + 512 + h * 128 + k]); o += exp2f((float)(t - s) * lg) * d * bf2f(DR[(size_t)(MP + b * 4 + s) * 2048 + 1024 + h * 128 + e]); }
        }
        __syncthreads(); red[e] = o * o; __syncthreads();
        for (int w = 64; w >= 1; w >>= 1) { if (e < w) red[e] += red[e + w]; __syncthreads(); }
        const float rn = rsqrtf(red[0] * (1.0f / 128) + EPS);
        REF[(size_t)row * 512 + h * 128 + e] = o * rn * a.in[19][l * 512 + h * 128 + e] * bf2f(DR[(size_t)row * 2048 + 1536 + h * 128 + e]);
    }
}
__global__ void nv_merge(Args a, int l) {
    const unsigned char* ws = a.ws; const bf16_t* BR = (const bf16_t*)(ws + WS_BR); const bf16_t* GATE = (const bf16_t*)(ws + WS_GATE); float* REF = (float*)(ws + WS_REF);
    for (size_t i = (size_t)blockIdx.x * blockDim.x + threadIdx.x; i < (size_t)MR * 2048; i += (size_t)gridDim.x * blockDim.x) {
        const int row = (int)(i >> 11), d = (int)(i & 2047); if (!chk_row(row)) continue;
        float m = 0.f;
        for (int n = 0; n < 4; ++n) { float acc = 0.f; const bf16_t* br = BR + ((size_t)n * MPAD + row) * 512; const float* w = a.in[20] + ((size_t)(l * 4 + n) * 512) * 2048 + d;
            for (int c = 0; c < 512; ++c) acc += bf2f(br[c]) * w[(size_t)c * 2048];
            m += bf2f(GATE[(size_t)row * 8192 + n * 2048 + d]) * acc; }
        REF[(size_t)row * 2048 + d] = m;
    }
}
__global__ void nv_cmp(const bf16_t* fast, const float* ref, int ncol, float* acc  ) {
    float np = 0.f, dp = 0.f, ns = 0.f, ds = 0.f;
    for (size_t i = (size_t)blockIdx.x * blockDim.x + threadIdx.x; i < (size_t)MR * ncol; i += (size_t)gridDim.x * blockDim.x) {
        const int row = (int)(i / ncol); if (!chk_row(row)) continue;
        const float f = bf2f(fast[i]), r = ref[i], df = f - r;
        if (row < MP) { np += df * df; dp += r * r; } else { ns += df * df; ds += r * r; }
    }
    np = wave_sum(np); dp = wave_sum(dp); ns = wave_sum(ns); ds = wave_sum(ds);
    if ((threadIdx.x & 63) == 0) { atomicAdd(acc + 0, np); atomicAdd(acc + 1, dp); atomicAdd(acc + 2, ns); atomicAdd(acc + 3, ds); }
}
__global__ void nv_report(const float* acc, float* ysample, int which  ) {
    const float rel = acc[2 * which] / fmaxf(acc[2 * which + 1], 1e-30f); const float c = 100.0f * sqrtf(sqrtf(fmaxf(rel, 1e-12f)));
    for (size_t i = (size_t)blockIdx.x * blockDim.x + threadIdx.x; i < (size_t)MS * DM; i += (size_t)gridDim.x * blockDim.x) ysample[i] = c;
}
#endif
#ifdef KEEP_EXPR
__global__ void dbg_keep(float* y) { for (size_t i = (size_t)blockIdx.x * blockDim.x + threadIdx.x; i < (size_t)MP * DM; i += (size_t)gridDim.x * blockDim.x) { const int row = (int)(i >> 11), col = (int)(i & 2047); (void)row; (void)col; if (!(KEEP_EXPR)) y[i] = 0.f; } }
#endif
#ifdef DBG_LAST
__global__ void dbg_dump(const float* src, float* dst, size_t n) { for (size_t i = (size_t)blockIdx.x * blockDim.x + threadIdx.x; i < n; i += (size_t)gridDim.x * blockDim.x) dst[i] = src[i]; }
#endif
extern "C" void kernel_launch(void* const* d_in, const int* in_sizes, int n_in, void* d_out, int out_size, void* d_ws, size_t ws_size, hipStream_t stream) {
    static int grid = 0;
    if (grid == 0) {
        if (n_in != 27 || out_size != (int)O_END || ws_size < WS_END) { fprintf(stderr, "kernel_launch: unexpected problem: n_in %d out %d ws %zu\n", n_in, out_size, ws_size); grid = -1; return; }
        int dev = 0, cus = 0, per_cu = 0;
        if (hipGetDevice(&dev) != hipSuccess || hipDeviceGetAttribute(&cus, hipDeviceAttributeMultiprocessorCount, dev) != hipSuccess) { grid = -1; return; }
        if (hipFuncSetAttribute((const void*)fwd, hipFuncAttributeMaxDynamicSharedMemorySize, LDS_BYTES) != hipSuccess) { fprintf(stderr, "kernel_launch: hipFuncSetAttribute failed\n"); grid = -1; return; }
        if (hipOccupancyMaxActiveBlocksPerMultiprocessor(&per_cu, (const void*)fwd, 512, LDS_BYTES) != hipSuccess || per_cu < 1) { fprintf(stderr, "kernel_launch: occupancy query says %d\n", per_cu); }
        (void)hipGetLastError();
        grid = cus;
    }
    if (grid < 0) return;
    (void)hipMemsetAsync((char*)d_ws + WS_CTL, 0, CTL_ZERO_BYTES, stream);
    Args a{};
    for (int i = 0; i < 27; ++i) a.in[i] = (const float*)d_in[i];
    a.out = (float*)d_out; a.ws = (unsigned char*)d_ws;
#if ONE_LAUNCH
    a.ph_lo = 0; a.ph_hi = NPHASE;
    hipLaunchKernelGGL(fwd, dim3(grid), dim3(512), LDS_BYTES, stream, a);
#else
#ifdef DBG_LAST
    for (int p = 0; p <= DBG_LAST; ++p) { a.ph_lo = p; a.ph_hi = p + 1; hipLaunchKernelGGL(fwd, dim3(grid), dim3(512), LDS_BYTES, stream, a); }
    hipLaunchKernelGGL(dbg_dump, dim3(2048), dim3(256), 0, stream, (const float*)((char*)d_ws + DBG_OFF), (float*)d_out, (size_t)DBG_N);
#else
    for (int p = 0; p < NPHASE; ++p) {
#ifdef SKIP_MASK
        if ((SKIP_MASK >> p) & 1) continue;
#endif
        a.ph_lo = p; a.ph_hi = p + 1; hipLaunchKernelGGL(fwd, dim3(grid), dim3(512), LDS_BYTES, stream, a);
#ifdef SELFCHK
        { const int L = SELFCHK_LAYER; float* acc = (float*)((char*)d_ws + WS_CTL) + 1024; unsigned char* w8 = (unsigned char*)d_ws;
          if (p == 1 + 9 * L + 4 && SELFCHK >= 1 && SELFCHK <= 3) {
              if (SELFCHK == 1) hipLaunchKernelGGL(nv_gmlp, dim3(2048), dim3(256), 0, stream, a, L);
              if (SELFCHK == 2) { hipLaunchKernelGGL(nv_pool_diff, dim3(2048), dim3(256), 0, stream, a, L); hipLaunchKernelGGL(nv_pool_mm, dim3(2048), dim3(256), 0, stream, a, L); }
              if (SELFCHK == 3) hipLaunchKernelGGL(nv_ret, dim3(2176), dim3(128), 0, stream, a, L);
              hipLaunchKernelGGL(nv_cmp, dim3(1024), dim3(256), 0, stream, (const bf16_t*)(w8 + WS_BR) + (size_t)SELFCHK * MPAD * 512, (const float*)(w8 + WS_REF), 512, acc); }
          if (p == 1 + 9 * L + 5 && SELFCHK == 4) {
              hipLaunchKernelGGL(nv_merge, dim3(4096), dim3(256), 0, stream, a, L);
              hipLaunchKernelGGL(nv_cmp, dim3(1024), dim3(256), 0, stream, (const bf16_t*)(w8 + WS_MG), (const float*)(w8 + WS_REF), 2048, acc); } }
#endif
    }
#ifdef SELFCHK
    hipLaunchKernelGGL(nv_report, dim3(256), dim3(256), 0, stream, (const float*)((char*)d_ws + WS_CTL) + 1024, (float*)d_out + (size_t)MP * DM, SELFCHK_WHICH);
#endif
#endif
#endif
#ifdef KEEP_EXPR
    hipLaunchKernelGGL(dbg_keep, dim3(2048), dim3(256), 0, stream, (float*)d_out);
#endif
#ifdef ZMASK
    { const size_t offs[14] = {0, (size_t)MP * DM, O_KVP0, O_KVP1, O_KVP2, O_KVS0, O_KVS1, O_KVS2, O_POOLP, O_POOLS, O_RETP, O_RETS, O_GVS, O_END};
      for (int k = 0; k < 13; ++k) if ((ZMASK >> k) & 1) hipLaunchKernelGGL(dbg_zero, dim3(256), dim3(256), 0, stream, (float*)d_out + offs[k], (offs[k + 1] - offs[k]) / 10); }
#endif
}
```

```cpp
#include <hip/hip_runtime.h>
#include <cstdio>
#include <cstdint>
#ifndef ONE_LAUNCH
#define ONE_LAUNCH 1
#endif
#ifndef PH_MASK
#define PH_MASK 0x1ff
#endif
#ifndef GP_ALIGN
#define GP_ALIGN true
#endif
#ifndef GP_SP2
#define GP_SP2 true
#endif
namespace pg8 {
#define PG8_LAS __attribute__((address_space(3)))
typedef unsigned short bf16_t;
typedef short bf16x8 __attribute__((ext_vector_type(8)));
typedef float f32x4 __attribute__((ext_vector_type(4)));
typedef unsigned u32x4 __attribute__((ext_vector_type(4)));
constexpr int BM = 256, BK = 64, HALF = 128, HTB = HALF * BK * 2  , STAGE_BYTES = 8 * HTB, NXCD = 8, WGM = 8;

__host__ __device__ __forceinline__ int lds_byte(int r, int c) { const int st = (r >> 4) * 2 + (c >> 5), rr = r & 15, cc = c & 31, ob = rr * 64 + cc * 2; return st * 1024 + (ob ^ (((ob >> 9) & 1) << 5)); }
__host__ __device__ __forceinline__ void stage_rc(int b, int& R, int& C) { const int st = b / 1024, sb = b % 1024, swz = sb ^ (((sb >> 9) & 1) << 5); R = (st >> 1) * 16 + swz / 64; C = (st & 1) * 32 + (swz % 64) / 2; }
__host__ __device__ __forceinline__ int perm32(int rho) { const int n = rho >> 4, i = rho & 15; return 8 * (i >> 2) + 4 * n + (i & 3); }

struct Unit { int pm, pn; };
struct Gemm { const bf16_t* A; const bf16_t* Bt; int M, N, K; };

struct StaticOrder {
    int nM, nN, nwg, G, c;
    __host__ __device__ void init(int M, int N, int G_, int c_) { nM = M / BM; nN = N / BM; nwg = nM * nN; G = G_; c = c_; }
    __host__ __device__ bool next(int i, Unit& u) const {
        const long L = (long)i * G + c; if (L >= nwg) return false;
        int wgid = (int)L; { const int q = nwg / NXCD, r = nwg % NXCD, xcd = wgid % NXCD, off = wgid / NXCD; wgid = (xcd < r ? xcd * (q + 1) : r * (q + 1) + (xcd - r) * q) + off; }
        const int nig = WGM * nN, gid = wgid / nig, fm = gid * WGM, gsz = (nM - fm) < WGM ? (nM - fm) : WGM;
        u.pm = fm + ((wgid % nig) % gsz); u.pn = (wgid % nig) / gsz; return true;
    }
    __device__ __forceinline__ void a_ready(const Unit&) const {}
    __device__ __forceinline__ void done(const Unit&) const {}
};
__device__ __forceinline__ unsigned cvt_pk_bf16(float lo, float hi) { unsigned r; asm volatile("v_cvt_pk_bf16_f32 %0, %1, %2" : "=v"(r) : "v"(lo), "v"(hi)); return r; }
typedef float f32x2 __attribute__((ext_vector_type(2)));
typedef int i32x4 __attribute__((ext_vector_type(4)));
typedef int i32x8 __attribute__((ext_vector_type(8)));
__device__ __forceinline__ f32x4 mma8(bf16x8 b0, bf16x8 b1, bf16x8 a0, bf16x8 a1, f32x4 c) {
    const i32x8 B = __builtin_shufflevector(__builtin_bit_cast(i32x4, b0), __builtin_bit_cast(i32x4, b1), 0, 1, 2, 3, 4, 5, 6, 7);
    const i32x8 A = __builtin_shufflevector(__builtin_bit_cast(i32x4, a0), __builtin_bit_cast(i32x4, a1), 0, 1, 2, 3, 4, 5, 6, 7);
    return __builtin_amdgcn_mfma_scale_f32_16x16x128_f8f6f4(B, A, c, 0, 0, 0, 0x7f7f7f7f, 0, 0x7f7f7f7f);
}
template <class Epi, class Sched, bool ALIGN_EPI = false, bool SP2 = false, bool F8 = false, int HALFPM = -1>
__device__ __forceinline__ void gemm_phase(PG8_LAS unsigned char* lds, const Gemm g, const Sched& S, const Epi& E) {
    const int tid = threadIdx.x, wid = __builtin_amdgcn_readfirstlane(tid >> 6), lane = tid & 63, wr = wid >> 2, wc = wid & 3, fr = lane & 15, fq = lane >> 4;
    const int K = g.K, nt = K / BK;
    unsigned voffA[2], voffB[2];
#pragma unroll
    for (int i = 0; i < 2; ++i) { int R, C; stage_rc(tid * 16 + i * 8192, R, C); const int Rb = Epi::PERM ? ((R & ~31) + perm32(R & 31)) : R;
        voffA[i] = (unsigned)(R * K + C) * 2u; voffB[i] = (unsigned)(Rb * K + C) * 2u; }
    const size_t kstep = (size_t)(BK * 2);
    const size_t hstep = (size_t)HALF * K * 2;
    const size_t tstep = 2 * hstep;
    const unsigned ldsw = (unsigned)wid * 1024u;
    const int aoff = lds_byte(wr * 64 + fr, fq * 8), boff = lds_byte(wc * 32 + fr, fq * 8);
#define PG8_SA(b, h) (((b) * 2 + (h)) * HTB)
#define PG8_SB(b, h) ((4 + (b) * 2 + (h)) * HTB)
#define PG8_STAGE(bufoff, gbase, voff) do { _Pragma("unroll") for (int _i = 0; _i < 2; ++_i) \
        __builtin_amdgcn_global_load_lds((const unsigned*)((const char*)(gbase) + (voff)[_i]), (PG8_LAS unsigned*)(lds + (bufoff) + ldsw + _i * 8192), 16, 0, 0); } while (0)
#define PG8_LD8(p) __builtin_shufflevector(*(const PG8_LAS i32x4*)(p), *(const PG8_LAS i32x4*)((p) + 1024), 0, 1, 2, 3, 4, 5, 6, 7)
#define PG8_LDA(dst, b, h) do { if constexpr (F8) { _Pragma("unroll") for (int m = 0; m < 4; ++m) dst##8[m] = PG8_LD8(lds + PG8_SA(b, h) + aoff + m * 2048); } \
        else { _Pragma("unroll") for (int m = 0; m < 4; ++m) _Pragma("unroll") for (int k = 0; k < 2; ++k) dst[m][k] = *(const PG8_LAS bf16x8*)(lds + PG8_SA(b, h) + aoff + m * 2048 + k * 1024); } } while (0)
#define PG8_LDB(dst, b, h) do { if constexpr (F8) { _Pragma("unroll") for (int n = 0; n < 2; ++n) dst##8[n] = PG8_LD8(lds + PG8_SB(b, h) + boff + n * 2048); } \
        else { _Pragma("unroll") for (int n = 0; n < 2; ++n) _Pragma("unroll") for (int k = 0; k < 2; ++k) dst[n][k] = *(const PG8_LAS bf16x8*)(lds + PG8_SB(b, h) + boff + n * 2048 + k * 1024); } } while (0)
#define PG8_MMA(ai, bj, At, Bt) do { __builtin_amdgcn_s_setprio(1); \
        if constexpr (F8) { _Pragma("unroll") for (int m = 0; m < 4; ++m) _Pragma("unroll") for (int n = 0; n < 2; ++n) asm volatile("v_mfma_scale_f32_16x16x128_f8f6f4 %0, %1, %2, %0, %3, %3 op_sel_hi:[0,0,0]" : "+v"(acc[ai][bj][m][n]) : "v"(Bt##8[n]), "v"(At##8[m]), "v"(0x7f7f7f7f)); } \
        else { _Pragma("unroll") for (int m = 0; m < 4; ++m) _Pragma("unroll") for (int n = 0; n < 2; ++n) _Pragma("unroll") for (int k = 0; k < 2; ++k) \
        acc[ai][bj][m][n] = __builtin_amdgcn_mfma_f32_16x16x32_bf16(Bt[n][k], At[m][k], acc[ai][bj][m][n], 0, 0, 0); } __builtin_amdgcn_s_setprio(0); } while (0)
#define PG8_WAIT_V(n) asm volatile("s_waitcnt vmcnt(" #n ")" ::: "memory")
#define PG8_WAIT_L(n) asm volatile("s_waitcnt lgkmcnt(" #n ")" ::: "memory")
#define PG8_BAR __builtin_amdgcn_s_barrier()
#define PG8_SCHED __builtin_amdgcn_sched_barrier(0)
    Unit cur, nxt; int ui = 0;
    if (!S.next(0, cur)) return;
    f32x4 acc[2][2][4][2];
#pragma unroll
    for (int a = 0; a < 2; ++a)
#pragma unroll
        for (int b = 0; b < 2; ++b)
#pragma unroll
            for (int m = 0; m < 4; ++m)
#pragma unroll
                for (int n = 0; n < 2; ++n) acc[a][b][m][n] = (f32x4){0.f, 0.f, 0.f, 0.f};
    bf16x8 At[4][2], B0[2][2], B1[2][2]; i32x8 At8[4], B08[2], B18[2];
    const char* cA = (const char*)g.A + (size_t)cur.pm * tstep; const char* cB = (const char*)g.Bt + (size_t)cur.pn * tstep;
    S.a_ready(cur);
    if constexpr (SP2) {
        PG8_STAGE(PG8_SB(0, 0), cB, voffB); PG8_STAGE(PG8_SB(0, 1), cB + hstep, voffB); PG8_STAGE(PG8_SA(0, 0), cA, voffA); PG8_STAGE(PG8_SA(0, 1), cA + hstep, voffA);
        if (wr == 1) PG8_BAR;
        PG8_WAIT_V(2); PG8_BAR;
        PG8_STAGE(PG8_SB(1, 0), cB + kstep, voffB); PG8_STAGE(PG8_SA(1, 0), cA + kstep, voffA); PG8_STAGE(PG8_SB(1, 1), cB + hstep + kstep, voffB);
        PG8_WAIT_V(6); PG8_BAR;
    } else {
        PG8_STAGE(PG8_SB(0, 0), cB, voffB); PG8_STAGE(PG8_SA(0, 0), cA, voffA); PG8_STAGE(PG8_SB(0, 1), cB + hstep, voffB); PG8_STAGE(PG8_SA(0, 1), cA + hstep, voffA);
        if (wr == 1) PG8_BAR;
        PG8_WAIT_V(4); PG8_BAR;
        PG8_STAGE(PG8_SB(1, 0), cB + kstep, voffB); PG8_STAGE(PG8_SA(1, 0), cA + kstep, voffA); PG8_STAGE(PG8_SB(1, 1), cB + hstep + kstep, voffB);
        PG8_WAIT_V(6); PG8_BAR;
    }
    for (;;) {
        const bool has_next = S.next(ui + 1, nxt);
        const char* nA = has_next ? (const char*)g.A + (size_t)nxt.pm * tstep : cA; const char* nB = has_next ? (const char*)g.Bt + (size_t)nxt.pn * tstep : cB;
        for (int t = 0; t < nt; t += 2) {
            const bool last = (t == nt - 2);
            const char* a1 = cA + (size_t)(t + 1) * kstep;
            const char* a2 = last ? nA : cA + (size_t)(t + 2) * kstep; const char* b2 = last ? nB : cB + (size_t)(t + 2) * kstep;
            const char* a3 = a2 + kstep; const char* b3 = b2 + kstep;
            if (last && has_next) S.a_ready(nxt);
            if constexpr (SP2) {
            PG8_LDB(B0, 0, 0); PG8_LDB(B1, 0, 1); PG8_SCHED; PG8_LDA(At, 0, 0); PG8_STAGE(PG8_SA(1, 1), a1 + hstep, voffA);
            PG8_WAIT_V(8); PG8_WAIT_L(0); PG8_BAR; PG8_MMA(0, 0, At, B0); PG8_MMA(0, 1, At, B1); PG8_BAR; PG8_SCHED;
            if (HALFPM < 0 || cur.pm != HALFPM) PG8_LDA(At, 0, 1); PG8_STAGE(PG8_SB(0, 0), b2, voffB); PG8_STAGE(PG8_SB(0, 1), b2 + hstep, voffB); PG8_STAGE(PG8_SA(0, 0), a2, voffA);
            PG8_WAIT_V(8); PG8_WAIT_L(0); PG8_BAR; if (HALFPM < 0 || cur.pm != HALFPM) { PG8_MMA(1, 0, At, B0); PG8_MMA(1, 1, At, B1); } PG8_BAR; PG8_SCHED;
            PG8_LDB(B0, 1, 0); PG8_LDB(B1, 1, 1); PG8_SCHED; PG8_LDA(At, 1, 0); PG8_STAGE(PG8_SA(0, 1), a2 + hstep, voffA);
            PG8_WAIT_V(8); PG8_WAIT_L(0); PG8_BAR; PG8_MMA(0, 0, At, B0); PG8_MMA(0, 1, At, B1); PG8_BAR; PG8_SCHED;
            if (HALFPM < 0 || cur.pm != HALFPM) PG8_LDA(At, 1, 1); PG8_STAGE(PG8_SB(1, 0), b3, voffB); PG8_STAGE(PG8_SB(1, 1), b3 + hstep, voffB); PG8_STAGE(PG8_SA(1, 0), a3, voffA);
            PG8_WAIT_V(8); PG8_WAIT_L(0); PG8_BAR; if (HALFPM < 0 || cur.pm != HALFPM) { PG8_MMA(1, 0, At, B0); PG8_MMA(1, 1, At, B1); } PG8_BAR; PG8_SCHED;
            } else {
            PG8_LDB(B0, 0, 0); PG8_SCHED; PG8_LDA(At, 0, 0); PG8_STAGE(PG8_SA(1, 1), a1 + hstep, voffA);
            PG8_WAIT_L(8); PG8_BAR; PG8_WAIT_L(0); PG8_MMA(0, 0, At, B0); PG8_BAR; PG8_SCHED;
            PG8_LDB(B1, 0, 1); PG8_STAGE(PG8_SB(0, 0), b2, voffB);
            PG8_BAR; PG8_WAIT_L(0); PG8_MMA(0, 1, At, B1); PG8_BAR;
            PG8_LDA(At, 0, 1); PG8_STAGE(PG8_SA(0, 0), a2, voffA);
            PG8_BAR; PG8_WAIT_L(0); PG8_MMA(1, 0, At, B0); PG8_BAR; PG8_SCHED;
            PG8_STAGE(PG8_SB(0, 1), b2 + hstep, voffB);
            PG8_WAIT_V(6); PG8_BAR; PG8_MMA(1, 1, At, B1); PG8_BAR;
            PG8_LDB(B0, 1, 0); PG8_SCHED; PG8_LDA(At, 1, 0); PG8_STAGE(PG8_SA(0, 1), a2 + hstep, voffA);
            PG8_WAIT_L(8); PG8_BAR; PG8_WAIT_L(0); PG8_MMA(0, 0, At, B0); PG8_BAR; PG8_SCHED;
            PG8_LDB(B1, 1, 1); PG8_STAGE(PG8_SB(1, 0), b3, voffB);
            PG8_BAR; PG8_WAIT_L(0); PG8_MMA(0, 1, At, B1); PG8_BAR;
            PG8_LDA(At, 1, 1); PG8_STAGE(PG8_SA(1, 0), a3, voffA);
            PG8_BAR; PG8_WAIT_L(0); PG8_MMA(1, 0, At, B0); PG8_BAR; PG8_SCHED;
            PG8_STAGE(PG8_SB(1, 1), b3 + hstep, voffB);
            PG8_WAIT_V(6); PG8_BAR; PG8_MMA(1, 1, At, B1); PG8_BAR;
            }
        }
        if constexpr (ALIGN_EPI) { if (wr == 0) PG8_BAR; }
        if constexpr (F8) asm volatile("s_nop 15\n\ts_nop 15\n\ts_nop 15\n\ts_nop 15" ::: "memory");
        if constexpr (!Epi::AFTER_DRAIN) { E(acc, cur, wr, wc, fr, fq); S.done(cur); }
        if (!has_next) break;
        if constexpr (!Epi::CARRY) {
#pragma unroll
        for (int a = 0; a < 2; ++a)
#pragma unroll
            for (int b = 0; b < 2; ++b)
#pragma unroll
                for (int m = 0; m < 4; ++m)
#pragma unroll
                    for (int n = 0; n < 2; ++n) acc[a][b][m][n] = (f32x4){0.f, 0.f, 0.f, 0.f};
        }
        cur = nxt; cA = nA; cB = nB; ++ui;
        if constexpr (ALIGN_EPI) { if (wr == 1) PG8_BAR; }
    }
    PG8_WAIT_V(0);
    if constexpr (!ALIGN_EPI) { if (wr == 0) PG8_BAR; }
    PG8_BAR;
    if constexpr (Epi::AFTER_DRAIN) { E.fused(acc, cur, wr, wc, fr, fq, lds, wid, lane); S.done(cur); }
#undef PG8_SA
#undef PG8_SB
#undef PG8_STAGE
#undef PG8_LDA
#undef PG8_LD8
#undef PG8_LDB
#undef PG8_MMA
#undef PG8_WAIT_V
#undef PG8_WAIT_L
#undef PG8_BAR
#undef PG8_SCHED
}
}
#define LAS __attribute__((address_space(3)))
#define XB_TMO      128
#define XB_XCNT(j)  (256  + 64 * (j))
#define XB_XSUB(j)  (1280 + 64 * (j))
#define XB_XGEN(j)  (2304 + 64 * (j))
#define XB_TOP      3328
#define XB_TOPGEN   3392
#define XCD_BAR_WORDS 3456
#define XB_SPIN_CAP (1u << 18)

__device__ __forceinline__ unsigned xb_ld(unsigned* p)              { return __hip_atomic_load(p, __ATOMIC_RELAXED, __HIP_MEMORY_SCOPE_AGENT); }
typedef unsigned long long u64;
constexpr float SS_FIX = 4294967296.0f, SS_INV = 1.0f / 4294967296.0f;
__device__ __forceinline__ u64 ss_fix(float s) { return (u64)(s * SS_FIX); }
__device__ __forceinline__ void ss_add(u64* p, float s) { __hip_atomic_fetch_add(p, ss_fix(s), __ATOMIC_RELAXED, __HIP_MEMORY_SCOPE_AGENT); }
__device__ __forceinline__ float ss_get(const u64* p) { return (float)(*p) * SS_INV; }
__device__ __forceinline__ unsigned xb_add(unsigned* p, unsigned v) { return __hip_atomic_fetch_add(p, v, __ATOMIC_RELAXED, __HIP_MEMORY_SCOPE_AGENT); }
__device__ __forceinline__ unsigned xb_xcc_id() { return (unsigned)__builtin_amdgcn_s_getreg((3 << 11) | 20) & 0xFu; }
#define XB_SPIN(cond, bar) do { unsigned _sp = 0; while (cond) { __builtin_amdgcn_s_sleep(1); \
    if ((++_sp & 255u) == 0u) { if (xb_ld(&(bar)[XB_TMO])) break; if (_sp > XB_SPIN_CAP) { atomicAdd(&(bar)[XB_TMO], 1u); break; } } } } while (0)

struct XcdBarrier {
    unsigned* bar; unsigned x;
    volatile LAS unsigned* st;
};

__device__ __forceinline__ XcdBarrier xcd_barrier_post(unsigned* bar, volatile LAS unsigned* st) {
    XcdBarrier b; b.bar = bar; b.x = xb_xcc_id(); b.st = st;
    if (threadIdx.x == 0) (void)xb_add(&bar[XB_XCNT(b.x)], 1u);
    return b;
}
__device__ __forceinline__ void xcd_barrier_complete(unsigned* bar, unsigned x, unsigned& nloc, unsigned& nx) {
    const unsigned G = gridDim.x * gridDim.y * gridDim.z;
    unsigned sum, cnt, mine, sp = 0u;
    for (;;) {
        sum = 0u; cnt = 0u; mine = 0u;
#pragma unroll
        for (unsigned j = 0; j < 16; ++j) { const unsigned c = xb_ld(&bar[XB_XCNT(j)]); sum += c; cnt += (c > 0u) ? 1u : 0u; mine = (j == x) ? c : mine; }
        if (sum == G) break;
        __builtin_amdgcn_s_sleep(1);
        if ((++sp & 255u) == 0u) { if (xb_ld(&bar[XB_TMO])) break; if (sp > XB_SPIN_CAP) { atomicAdd(&bar[XB_TMO], 1u); break; } }
    }
    nloc = mine > 0u ? mine : 1u; nx = cnt > 0u ? cnt : 1u;
}

__device__ __forceinline__ void xcd_barrier(const XcdBarrier& b) {
    asm volatile("s_waitcnt vmcnt(0)" ::: "memory");
    __syncthreads();
    if (threadIdx.x == 0) {
        unsigned* bar = b.bar;
        __builtin_amdgcn_s_waitcnt(0);
        unsigned nloc = b.st[0], nx = b.st[1];
        if (nloc == 0u) { xcd_barrier_complete(bar, b.x, nloc, nx); b.st[0] = nloc; b.st[1] = nx; }
        const unsigned old = xb_add(&bar[XB_XSUB(b.x)], 1u);
        const unsigned gen = old / nloc;
        if (old + 1u == (gen + 1u) * nloc) {
            __builtin_amdgcn_fence(__ATOMIC_RELEASE, "agent");
            asm volatile("s_waitcnt vmcnt(0)" ::: "memory");
            const unsigned og = xb_add(&bar[XB_TOP], 1u);
            const unsigned tg = og / nx;
            if (og + 1u == (tg + 1u) * nx) xb_add(&bar[XB_TOPGEN], 1u);
            else XB_SPIN(xb_ld(&bar[XB_TOPGEN]) == tg, bar);
            __builtin_amdgcn_fence(__ATOMIC_ACQUIRE, "agent");
            xb_add(&bar[XB_XGEN(b.x)], 1u);
            asm volatile("s_waitcnt vmcnt(0)" ::: "memory");
        } else {
            XB_SPIN(xb_ld(&bar[XB_XGEN(b.x)]) == gen, bar);
            __builtin_amdgcn_fence(__ATOMIC_ACQUIRE, "agent");
            asm volatile("s_waitcnt vmcnt(0)" ::: "memory");
        }
    }
    __syncthreads();
}

using pg8::bf16_t; using pg8::bf16x8; using pg8::f32x4; using pg8::u32x4;
typedef unsigned u32x2 __attribute__((ext_vector_type(2)));
typedef float f32x2v __attribute__((ext_vector_type(2)));
constexpr int DM = 2048, DFF = 5632, INW = 16384;
constexpr int MP = 8192, MS = 128, MR = 8320, MPAD = 8448;
constexpr int NPHASE = 20;
constexpr float EPS = 1e-6f, LOG2E = 1.4426950408889634f;
constexpr float ATT_SC = 0.08838834764831845f * 1.4426950408889634f;
constexpr size_t O_Y = 0;
constexpr size_t O_KVP0 = (size_t)MR * DM;
constexpr size_t O_KVP1 = O_KVP0 + (size_t)2 * 4 * 128 * 1024;
constexpr size_t O_KVP2 = O_KVP1 + (size_t)2 * 4 * 512 * 1024;
constexpr size_t O_KVS0 = O_KVP2 + (size_t)2 * 4 * 2048 * 1024;
constexpr size_t O_KVS1 = O_KVS0 + (size_t)2 * 32 * 4 * 1024;
constexpr size_t O_KVS2 = O_KVS1 + (size_t)2 * 32 * 4 * 1024;
constexpr size_t O_POOLP = O_KVS2 + (size_t)2 * 32 * 4 * 1024;
constexpr size_t O_POOLS = O_POOLP + (size_t)2 * 4 * 15 * 512;
constexpr size_t O_RETP = O_POOLS + (size_t)2 * 32 * 15 * 512;
constexpr size_t O_RETS = O_RETP + (size_t)2 * 4 * 4 * 16384;
constexpr size_t O_GVS = O_RETS + (size_t)2 * 32 * 4 * 16384;
constexpr size_t O_END = O_GVS + (size_t)2 * 32 * 4 * 512;
static_assert(O_END == 45248512, "output map");
constexpr size_t MiB = 1u << 20;
constexpr size_t WS_CTL = 0, CTL_ZERO_BYTES = 1 * MiB;
constexpr size_t WS_ROT = 1 * MiB, WS_WPT = 3 * MiB, WS_W = 4 * MiB, W_LAYER = 212 * MiB;
constexpr size_t WL_GU1 = 0, WL_D1 = 44 * MiB, WL_IN = 66 * MiB, WL_B = 130 * MiB, WL_O = 138 * MiB, WL_GU2 = 146 * MiB, WL_D2 = 190 * MiB;
constexpr size_t WS_X = 428 * MiB, WS_XB = 494 * MiB, WS_G = 527 * MiB, WS_QKV = 618 * MiB, WS_BU = 693 * MiB, WS_BV = 702 * MiB, WS_CIN = 719 * MiB, WS_DR = 736 * MiB,
                 WS_GATE = 769 * MiB, WS_AO = 901 * MiB, WS_LSE = 926 * MiB, WS_BR = 927 * MiB, WS_LOC = 960 * MiB, WS_PM = 976 * MiB, WS_MG = 1042 * MiB, WS_XB8 = 1076 * MiB, WS_G8 = 1094 * MiB, WS_WD8 = 1142 * MiB, WS_END = 1190 * MiB;
constexpr int CW_BAR = 4096, CW_WQ = 12288, CW_SS = 16384;
static_assert(CW_SS * 4 + 9 * MPAD * 8 <= (int)CTL_ZERO_BYTES, "ctl");
constexpr int RING_BYTES = 131072, MISC_OFF = RING_BYTES + 320, LDS_BYTES = 147456;
constexpr int TS_ = 272, TILE = 128 * TS_;

__device__ const unsigned char BUCKET[3][132] = {
 {0,1,2,3,4,5,6,7,8,9,10,11,12,13,14,15,16,16,16,16,16,16,17,17,17,17,17,17,17,17,18,18,18,18,18,18,18,18,18,18,19,19,19,19,19,19,19,19,19,19,19,19,19,19,20,20,20,20,20,20,20,20,20,20,20,20,20,20,20,20,20,20,20,21,21,21,21,21,21,21,21,21,21,21,21,21,21,21,21,21,21,21,21,21,21,21,21,21,21,22,22,22,22,22,22,22,22,22,22,22,22,22,22,22,22,22,22,22,22,22,22,22,22,22,22,22,22,22,22,0,0,0},
 {0,4,8,12,16,16,17,17,18,18,19,19,19,19,20,20,20,20,20,21,21,21,21,21,21,22,22,22,22,22,22,22,22,22,23,23,23,23,23,23,23,23,23,23,23,23,24,24,24,24,24,24,24,24,24,24,24,24,24,24,24,24,25,25,25,25,25,25,25,25,25,25,25,25,25,25,25,25,25,25,25,25,25,26,26,26,26,26,26,26,26,26,26,26,26,26,26,26,26,26,26,26,26,26,26,26,26,26,26,26,26,26,26,27,27,27,27,27,27,27,27,27,27,27,27,27,27,27,27,0,0,0},
 {0,16,18,19,20,21,21,22,22,23,23,23,24,24,24,24,25,25,25,25,25,26,26,26,26,26,26,26,26,27,27,27,27,27,27,27,27,27,27,28,28,28,28,28,28,28,28,28,28,28,28,28,29,29,29,29,29,29,29,29,29,29,29,29,29,29,29,29,29,29,30,30,30,30,30,30,30,30,30,30,30,30,30,30,30,30,30,30,30,30,30,30,30,30,30,31,31,31,31,31,31,31,31,31,31,31,31,31,31,31,31,31,31,31,31,31,31,31,31,31,31,31,31,31,31,31,31,31,31,0,0,0}};

constexpr size_t W8_OFF = (size_t)36 << 20;
constexpr float X8_SCALE = 8.0f, W8_SCALE = 64.0f;
#ifndef FUSE_MIX
#define FUSE_MIX 1
#endif
#ifndef FUSE_FINAL
#define FUSE_FINAL 1
#endif
#ifndef SKIP_PM
#define SKIP_PM 32
#endif
#ifndef D8_MASK
#define D8_MASK 12
#endif
__device__ __forceinline__ unsigned pk4_fp8(float a, float b, float c, float d) { int w = __builtin_amdgcn_cvt_pk_fp8_f32(a, b, 0, false); w = __builtin_amdgcn_cvt_pk_fp8_f32(c, d, w, true); return (unsigned)w; }
__device__ __forceinline__ unsigned pk2(float lo, float hi) { return pg8::cvt_pk_bf16(lo, hi); }
__device__ __forceinline__ bf16_t f2bf(float f) { return (bf16_t)(pk2(f, f) & 0xffffu); }
__device__ __forceinline__ float bf2f(unsigned v) { return __uint_as_float(v << 16); }
__device__ __forceinline__ float bflo(unsigned w) { return __uint_as_float(w << 16); }
__device__ __forceinline__ float bfhi(unsigned w) { return __uint_as_float(w & 0xffff0000u); }
__device__ __forceinline__ float fast_rcp(float x) { return __builtin_amdgcn_rcpf(x); }
__device__ __forceinline__ float fexp2(float x) { return __builtin_amdgcn_exp2f(x); }
__device__ __forceinline__ float sigmoidf_(float x) { return fast_rcp(1.0f + fexp2(-LOG2E * x)); }
__device__ __forceinline__ float siluf_(float x) { return x * sigmoidf_(x); }
__device__ __forceinline__ float gelu_tanh(float x) { const float y = 0.7978845608028654f * (x + 0.044715f * x * x * x); return x * sigmoidf_(2.0f * y); }
__device__ __forceinline__ float wave_sum(float v) {
#pragma unroll
    for (int o = 1; o < 64; o <<= 1) v += __shfl_xor(v, o);
    return v;
}
__device__ __forceinline__ float wave_max(float v) {
#pragma unroll
    for (int o = 1; o < 64; o <<= 1) v = fmaxf(v, __shfl_xor(v, o));
    return v;
}
__device__ __forceinline__ float lg2gamma(int h) { return __log2f(1.0f - exp2f(-5.0f - (float)h)); }

struct Args { const float* in[27]; float* out; unsigned char* ws; int ph_lo, ph_hi; };
typedef const Args __attribute__((address_space(4)))* KArgs;
struct Ctx {
    LAS unsigned char* lds;
    int tid, lane, wave, G, bid;
    KArgs a;
    float* out; unsigned char* ws;
    u64* ssbase;
};
#define WSP(T, off) ((T*)(C.ws + (off)))

struct EpiGU {
    static constexpr bool PERM = true, AFTER_DRAIN = false, CARRY = false;
    bf16_t* G; const u64* ss; unsigned char* G8;
    __device__ __forceinline__ void operator()(const f32x4 (&acc)[2][2][4][2], const pg8::Unit& u, int wr, int wc, int fr, int fq) const {
        const int col0 = u.pn * 128 + wc * 32 + 8 * fq;
#pragma unroll
        for (int ai = 0; ai < 2; ++ai) {
            if (u.pm == 32 && ai == 1) break;
#pragma unroll
            for (int m = 0; m < 4; ++m) {
                const int row = u.pm * 256 + ai * 128 + wr * 64 + m * 16 + fr;
                const float r = rsqrtf(ss_get(ss + row) * (1.0f / DM) + EPS);
                float h[8];
#pragma unroll
                for (int n = 0; n < 2; ++n)
#pragma unroll
                    for (int e = 0; e < 4; ++e) { const float g = acc[ai][0][m][n][e] * r, up = acc[ai][1][m][n][e] * r; h[4 * n + e] = siluf_(g) * up; }
                u32x4 w; w.x = pk2(h[0], h[1]); w.y = pk2(h[2], h[3]); w.z = pk2(h[4], h[5]); w.w = pk2(h[6], h[7]);
                if (!G8) *(u32x4*)(G + (size_t)row * DFF + col0) = w;
                if (G8) { u32x2 w8; w8.x = pk4_fp8(h[0] * X8_SCALE, h[1] * X8_SCALE, h[2] * X8_SCALE, h[3] * X8_SCALE); w8.y = pk4_fp8(h[4] * X8_SCALE, h[5] * X8_SCALE, h[6] * X8_SCALE, h[7] * X8_SCALE); *(u32x2*)(G8 + (size_t)row * DFF + col0) = w8; }
            }
        }
    }
};
struct EpiRes {
    static constexpr bool PERM = true, AFTER_DRAIN = false, CARRY = false;
    float* X; bf16_t* XB; u64* ssn; unsigned char* XB8; float alpha;
    __device__ __forceinline__ void operator()(const f32x4 (&acc)[2][2][4][2], const pg8::Unit& u, int wr, int wc, int fr, int fq) const {
        const int col0 = u.pn * 256 + wc * 32 + 8 * fq;
#pragma unroll
        for (int ai = 0; ai < 2; ++ai) {
            if (u.pm == 32 && ai == 1) break;
#pragma unroll
            for (int m = 0; m < 4; ++m) {
                const int row = u.pm * 256 + ai * 128 + wr * 64 + m * 16 + fr;
                float s = 0.f;
#pragma unroll
                for (int bj = 0; bj < 2; ++bj) {
                    bf16_t* xbp = XB + (size_t)row * DM + col0 + bj * 128;
                    const u32x4 xo = *(const u32x4*)xbp;
                    f32x4 x0 = (f32x4){bflo(xo.x), bfhi(xo.x), bflo(xo.y), bfhi(xo.y)}, x1 = (f32x4){bflo(xo.z), bfhi(xo.z), bflo(xo.w), bfhi(xo.w)};
                    x0 += acc[ai][bj][m][0] * alpha; x1 += acc[ai][bj][m][1] * alpha;
                    u32x4 w; w.x = pk2(x0[0], x0[1]); w.y = pk2(x0[2], x0[3]); w.z = pk2(x1[0], x1[1]); w.w = pk2(x1[2], x1[3]);
                    *(u32x4*)xbp = w;
                    { const float a0 = x0[0] * X8_SCALE, a1 = x0[1] * X8_SCALE, a2 = x0[2] * X8_SCALE, a3 = x0[3] * X8_SCALE, a4 = x1[0] * X8_SCALE, a5 = x1[1] * X8_SCALE, a6 = x1[2] * X8_SCALE, a7 = x1[3] * X8_SCALE;
                      if (XB8) { const unsigned lo = pk4_fp8(a0, a1, a2, a3), hi = pk4_fp8(a4, a5, a6, a7); unsigned* p8 = (unsigned*)(XB8 + (size_t)row * DM + col0 + bj * 128); p8[0] = lo; p8[1] = hi; } }
                    s += (x0[0] * x0[0] + x0[1] * x0[1]) + (x0[2] * x0[2] + x0[3] * x0[3]) + (x1[0] * x1[0] + x1[1] * x1[1]) + (x1[2] * x1[2] + x1[3] * x1[3]);
                }
                s += __shfl_xor(s, 16); s += __shfl_xor(s, 32);
                if (fq == 0) ss_add(ssn + row, s);
            }
        }
    }
};
struct EpiResFinal {
    static constexpr bool PERM = true, AFTER_DRAIN = true, CARRY = false;
    const bf16_t* XB; u64* ssn; const float* gain; float* out; unsigned* cnt; unsigned* bar; float alpha;
    __device__ __forceinline__ void fused(f32x4 (&acc)[2][2][4][2], const pg8::Unit& u, int wr, int wc, int fr, int fq, LAS unsigned char*, int, int) const {
        const int col0 = u.pn * 256 + wc * 32 + 8 * fq;
#pragma unroll
        for (int ai = 0; ai < 2; ++ai)
#pragma unroll
            for (int m = 0; m < 4; ++m) {
                const int row = u.pm * 256 + ai * 128 + wr * 64 + m * 16 + fr;
                float s = 0.f;
#pragma unroll
                for (int bj = 0; bj < 2; ++bj) {
                    const u32x4 xo = *(const u32x4*)(XB + (size_t)row * DM + col0 + bj * 128);
                    const f32x4 x0 = (f32x4){bflo(xo.x), bfhi(xo.x), bflo(xo.y), bfhi(xo.y)} + acc[ai][bj][m][0] * alpha, x1 = (f32x4){bflo(xo.z), bfhi(xo.z), bflo(xo.w), bfhi(xo.w)} + acc[ai][bj][m][1] * alpha;
                    acc[ai][bj][m][0] = x0; acc[ai][bj][m][1] = x1;
                    s += (x0[0] * x0[0] + x0[1] * x0[1]) + (x0[2] * x0[2] + x0[3] * x0[3]) + (x1[0] * x1[0] + x1[1] * x1[1]) + (x1[2] * x1[2] + x1[3] * x1[3]);
                }
                s += __shfl_xor(s, 16); s += __shfl_xor(s, 32);
                if (fq == 0) ss_add(ssn + row, s);
            }
        asm volatile("s_waitcnt vmcnt(0)" ::: "memory");
        __syncthreads();
        if (threadIdx.x == 0) {
            __builtin_amdgcn_fence(__ATOMIC_RELEASE, "agent"); asm volatile("s_waitcnt vmcnt(0)" ::: "memory");
            (void)xb_add(cnt + u.pm, 1u);
            XB_SPIN(xb_ld(cnt + u.pm) < 8u, bar);
            __builtin_amdgcn_fence(__ATOMIC_ACQUIRE, "agent"); asm volatile("s_waitcnt vmcnt(0)" ::: "memory");
        }
        __syncthreads();
#pragma unroll
        for (int ai = 0; ai < 2; ++ai)
#pragma unroll
            for (int m = 0; m < 4; ++m) {
                const int row = u.pm * 256 + ai * 128 + wr * 64 + m * 16 + fr;
                const float r = rsqrtf(ss_get(ssn + row) * (1.0f / DM) + EPS);
#pragma unroll
                for (int bj = 0; bj < 2; ++bj) {
                    const int col = col0 + bj * 128; const f32x4 g0 = *(const f32x4*)(gain + col), g1 = *(const f32x4*)(gain + col + 4);
                    float* yp = out + (size_t)row * DM + col;
                    __builtin_nontemporal_store(acc[ai][bj][m][0] * r * g0, (f32x4*)yp); __builtin_nontemporal_store(acc[ai][bj][m][1] * r * g1, (f32x4*)(yp + 4));
                }
            }
    }
};
struct EpiMerge {
    static constexpr bool PERM = true, AFTER_DRAIN = false, CARRY = true;
    const bf16_t* GATE; bf16_t* MG; int layer;
    __device__ __forceinline__ void operator()(f32x4 (&acc)[2][2][4][2], const pg8::Unit& u, int wr, int wc, int fr, int fq) const {
        const int nbr = u.pn >> 3, upn = u.pn & 7, upm = u.pm - (MPAD / 256) * nbr;
        const int col0 = upn * 256 + wc * 32 + 8 * fq;
#pragma unroll
        for (int ai = 0; ai < 2; ++ai) {
#pragma unroll
            for (int m = 0; m < 4; ++m) {
                const int row = upm * 256 + ai * 128 + wr * 64 + m * 16 + fr;
#pragma unroll
                for (int bj = 0; bj < 2; ++bj) {
                    const int col = col0 + bj * 128;
                    const bf16_t* gp = GATE + (size_t)row * 8192 + nbr * 2048 + col;
                    const u32x4 gw = *(const u32x4*)gp;
                    f32x4 v0 = acc[ai][bj][m][0], v1 = acc[ai][bj][m][1];
                    v0[0] *= bflo(gw.x); v0[1] *= bfhi(gw.x); v0[2] *= bflo(gw.y); v0[3] *= bfhi(gw.y);
                    v1[0] *= bflo(gw.z); v1[1] *= bfhi(gw.z); v1[2] *= bflo(gw.w); v1[3] *= bfhi(gw.w);
                    if (nbr < 3) { acc[ai][bj][m][0] = v0; acc[ai][bj][m][1] = v1;
                    } else { u32x4 w; w.x = pk2(v0[0], v0[1]); w.y = pk2(v0[2], v0[3]); w.z = pk2(v1[0], v1[1]); w.w = pk2(v1[2], v1[3]); *(u32x4*)(MG + (size_t)row * DM + col) = w; }
                }
            }
        }
    }
};
struct EpiGate {
    static constexpr bool PERM = true, AFTER_DRAIN = false, CARRY = false;
    const u64* ss; bf16_t* GATE; bf16_t* QKV;
    __device__ __forceinline__ void operator()(const f32x4 (&acc)[2][2][4][2], const pg8::Unit& u, int wr, int wc, int fr, int fq) const {
        const int cl = wc * 32 + 8 * fq;
#pragma unroll
        for (int ai = 0; ai < 2; ++ai) {
            if (u.pm == 32 && ai == 1) break;
#pragma unroll
            for (int m = 0; m < 4; ++m) {
                const int row = u.pm * 256 + ai * 128 + wr * 64 + m * 16 + fr;
                const float r = rsqrtf(ss_get(ss + row) * (1.0f / DM) + EPS) * (1.0f / (X8_SCALE * W8_SCALE));
                if (u.pn < 6) {
#pragma unroll
                    for (int bj = 0; bj < 2; ++bj) {
                        const f32x4 a = acc[ai][bj][m][0] * r, b = acc[ai][bj][m][1] * r;
                        u32x4 w; w.x = pk2(a[0], a[1]); w.y = pk2(a[2], a[3]); w.z = pk2(b[0], b[1]); w.w = pk2(b[2], b[3]);
                        *(u32x4*)(QKV + (size_t)row * 4608 + u.pn * 256 + bj * 128 + cl) = w;
                    }
                } else {
                    f32x4 g[4];
#pragma unroll
                    for (int b = 0; b < 4; ++b)
#pragma unroll
                        for (int e = 0; e < 4; ++e) g[b][e] = sigmoidf_(acc[ai][b >> 1][m][b & 1][e] * r);
                    bf16_t* gp = GATE + (size_t)row * 8192 + (u.pn - 6) * 64 + wc * 16 + 4 * fq;
#pragma unroll
                    for (int b = 0; b < 4; ++b) {
                        f32x4 h = g[b];
                        if (b < 3) {
#pragma unroll
                            for (int e = 0; e < 4; ++e) h[e] *= __builtin_amdgcn_rcpf(fmaxf(g[b + 1][e], 1e-30f));
                        }
                        u32x2 w; w.x = pk2(h[0], h[1]); w.y = pk2(h[2], h[3]); *(u32x2*)(gp + b * 2048) = w;
                    }
                }
            }
        }
    }
};
struct EpiIn {
    static constexpr bool PERM = true, AFTER_DRAIN = false, CARRY = false;
    const u64* ss; bf16_t* QKV; bf16_t* BU; float* BV; float* CIN; bf16_t* DR; bf16_t* GATE; u64* ssv; const float* ROT; float* out; int layer; int pn0;
    __device__ __forceinline__ void operator()(const f32x4 (&acc)[2][2][4][2], const pg8::Unit& u, int wr, int wc, int fr, int fq) const {
        const int pn = u.pn + pn0, cl = wc * 32 + 8 * fq;
#pragma unroll
        for (int ai = 0; ai < 2; ++ai) {
            if (u.pm == 32 && ai == 1) break;
#pragma unroll
            for (int m = 0; m < 4; ++m) {
                const int row = u.pm * 256 + ai * 128 + wr * 64 + m * 16 + fr;
                const float r = rsqrtf(ss_get(ss + row) * (1.0f / DM) + EPS);
                const bool samp = row >= MP; const int rs = row - MP;
                f32x4 v[2][2];
#pragma unroll
                for (int bj = 0; bj < 2; ++bj)
#pragma unroll
                    for (int n = 0; n < 2; ++n) v[bj][n] = acc[ai][bj][m][n] * r;
                if (pn < 18) {
#pragma unroll
                    for (int bj = 0; bj < 2; ++bj) {
                        u32x4 w; w.x = pk2(v[bj][0][0], v[bj][0][1]); w.y = pk2(v[bj][0][2], v[bj][0][3]); w.z = pk2(v[bj][1][0], v[bj][1][1]); w.w = pk2(v[bj][1][2], v[bj][1][3]);
                        *(u32x4*)(QKV + (size_t)row * 4608 + pn * 256 + bj * 128 + cl) = w;
                    }
                    if (pn >= 6) {
                        const int kv = pn >= 12 ? 1 : 0, x = pn - 6 - 6 * kv, gi = x >> 1, hp = x & 1, keep = 128 << (2 * gi);
                        long off = -1;
                        if (!samp) { const int b = row >> 11, t = row & 2047, tp = t - (2048 - keep);
                            if (tp >= 0) off = (long)(gi == 0 ? O_KVP0 : (gi == 1 ? O_KVP1 : O_KVP2)) + ((((long)(layer * 4 + b) * keep + tp) * 2 + kv) * 4 + 2 * hp) * 128 + cl; }
                        else { const int b = rs >> 2, s = rs & 3; off = (long)(gi == 0 ? O_KVS0 : (gi == 1 ? O_KVS1 : O_KVS2)) + ((((long)(layer * 32 + b) * 4 + s) * 2 + kv) * 4 + 2 * hp) * 128 + cl; }
                        if (off >= 0) {
#pragma unroll
                            for (int bj = 0; bj < 2; ++bj) { *(f32x4*)(out + off + bj * 128) = v[bj][0]; *(f32x4*)(out + off + bj * 128 + 4) = v[bj][1]; }
                        }
                    }
                } else if (pn < 20) {
#pragma unroll
                    for (int bj = 0; bj < 2; ++bj) {
                        float h[8];
#pragma unroll
                        for (int n = 0; n < 2; ++n)
#pragma unroll
                            for (int e = 0; e < 4; ++e) h[4 * n + e] = gelu_tanh(v[bj][n][e]);
                        u32x4 w; w.x = pk2(h[0], h[1]); w.y = pk2(h[2], h[3]); w.z = pk2(h[4], h[5]); w.w = pk2(h[6], h[7]);
                        *(u32x4*)(BU + (size_t)row * 512 + (pn - 18) * 256 + bj * 128 + cl) = w;
                    }
                } else if (pn < 22) {
                    float s = 0.f;
#pragma unroll
                    for (int bj = 0; bj < 2; ++bj) {
                        f32x4 h0, h1;
#pragma unroll
                        for (int e = 0; e < 4; ++e) { h0[e] = gelu_tanh(v[bj][0][e]); h1[e] = gelu_tanh(v[bj][1][e]); s += h0[e] * h0[e] + h1[e] * h1[e]; }
                        float* p = BV + (size_t)row * 512 + (pn - 20) * 256 + bj * 128 + cl;
                        *(f32x4*)p = h0; *(f32x4*)(p + 4) = h1;
                    }
                    s += __shfl_xor(s, 16); s += __shfl_xor(s, 32);
                    if (fq == 0) ss_add(ssv + row, s);
                } else if (pn < 24) {
                    const int c0 = (pn - 22) * 256 + cl;
                    long off = -1;
                    if (!samp) { const int b = row >> 11, t = row & 2047; if (t >= 2033) off = (long)O_POOLP + ((long)(layer * 4 + b) * 15 + (t - 2033)) * 512 + c0; }
                    else { const int b = rs >> 2, s = rs & 3; off = (long)O_POOLS + ((long)(layer * 32 + b) * 15 + 11 + s) * 512 + c0; }
#pragma unroll
                    for (int bj = 0; bj < 2; ++bj) {
                        float* p = CIN + (size_t)row * 512 + c0 + bj * 128;
                        *(f32x4*)p = v[bj][0]; *(f32x4*)(p + 4) = v[bj][1];
                        if (off >= 0) { *(f32x4*)(out + off + bj * 128) = v[bj][0]; *(f32x4*)(out + off + bj * 128 + 4) = v[bj][1]; }
                    }
                } else if (pn < 28) {
                    const int which = (pn - 24) >> 1, hp = (pn - 24) & 1, j0 = 16 * wc + 4 * fq;
                    const int pidx = samp ? 2048 + (rs & 3) : (row & 2047);
                    const f32x4 cs0 = *(const f32x4*)(ROT + ((size_t)pidx * 64 + j0) * 2), cs1 = *(const f32x4*)(ROT + ((size_t)pidx * 64 + j0) * 2 + 4);
                    const float cc[4] = {cs0[0], cs0[2], cs1[0], cs1[2]}, sn[4] = {cs0[1], cs0[3], cs1[1], cs1[3]};
                    const float ks = which ? 0.08838834764831845f : 1.0f;
#pragma unroll
                    for (int bj = 0; bj < 2; ++bj) {
                        float o1[4], o2[4];
#pragma unroll
                        for (int e = 0; e < 4; ++e) { const float x1 = v[bj][0][e], x2 = v[bj][1][e]; o1[e] = (x1 * cc[e] - x2 * sn[e]) * ks; o2[e] = (x1 * sn[e] + x2 * cc[e]) * ks; }
                        bf16_t* p = DR + (size_t)row * 2048 + which * 512 + (2 * hp + bj) * 128 + j0;
                        u32x2 w1, w2; w1.x = pk2(o1[0], o1[1]); w1.y = pk2(o1[2], o1[3]); w2.x = pk2(o2[0], o2[1]); w2.y = pk2(o2[2], o2[3]);
                        *(u32x2*)p = w1; *(u32x2*)(p + 64) = w2;
                    }
                } else if (pn < 32) {
                    const bool isg = pn >= 30;
#pragma unroll
                    for (int bj = 0; bj < 2; ++bj) {
                        float h[8];
#pragma unroll
                        for (int n = 0; n < 2; ++n)
#pragma unroll
                            for (int e = 0; e < 4; ++e) h[4 * n + e] = isg ? siluf_(v[bj][n][e]) : v[bj][n][e];
                        u32x4 w; w.x = pk2(h[0], h[1]); w.y = pk2(h[2], h[3]); w.z = pk2(h[4], h[5]); w.w = pk2(h[6], h[7]);
                        *(u32x4*)(DR + (size_t)row * 2048 + 1024 + (pn - 28) * 256 + bj * 128 + cl) = w;
                    }
                } else {
#pragma unroll
                    for (int bj = 0; bj < 2; ++bj) {
                        float h[8];
#pragma unroll
                        for (int n = 0; n < 2; ++n)
#pragma unroll
                            for (int e = 0; e < 4; ++e) h[4 * n + e] = sigmoidf_(v[bj][n][e]);
                        u32x4 w; w.x = pk2(h[0], h[1]); w.y = pk2(h[2], h[3]); w.z = pk2(h[4], h[5]); w.w = pk2(h[6], h[7]);
                        *(u32x4*)(GATE + (size_t)row * 8192 + (pn - 32) * 256 + bj * 128 + cl) = w;
                    }
                }
            }
        }
    }
};

__device__ __forceinline__ void conv_item(const float* src, int ld, int col4, const float* gain, bf16_t* dst, int K, int R0, int k0, LAS float* scr, int lane, unsigned char* dst8 = nullptr) {
    const int kr = lane >> 3, c4 = lane & 7;
    f32x4 v[8];
#pragma unroll
    for (int i = 0; i < 8; ++i) v[i] = __builtin_nontemporal_load((const f32x4*)(src + (size_t)(k0 + 8 * i + kr) * ld + col4));
#pragma unroll
    for (int i = 0; i < 8; ++i) { const float gk = gain ? gain[k0 + 8 * i + kr] : 1.0f; LAS float* s = scr + (8 * i + kr) * 33 + 4 * c4; s[0] = v[i][0] * gk; s[1] = v[i][1] * gk; s[2] = v[i][2] * gk; s[3] = v[i][3] * gk; }
    asm volatile("s_waitcnt lgkmcnt(0)" ::: "memory");
    const int c = lane & 7;
#pragma unroll
    for (int j = 0; j < 4; ++j) { const int n = (lane >> 3) + 8 * j; const LAS float* s = scr + (8 * c) * 33 + n;
        u32x4 o; o.x = pk2(s[0 * 33], s[1 * 33]); o.y = pk2(s[2 * 33], s[3 * 33]); o.z = pk2(s[4 * 33], s[5 * 33]); o.w = pk2(s[6 * 33], s[7 * 33]);
        if (dst) *(u32x4*)(dst + (size_t)(R0 + n) * K + k0 + 8 * c) = o;
        if (dst8) { u32x2 o8; o8.x = pk4_fp8(s[0 * 33] * W8_SCALE, s[1 * 33] * W8_SCALE, s[2 * 33] * W8_SCALE, s[3 * 33] * W8_SCALE); o8.y = pk4_fp8(s[4 * 33] * W8_SCALE, s[5 * 33] * W8_SCALE, s[6 * 33] * W8_SCALE, s[7 * 33] * W8_SCALE);
            *(u32x2*)(dst8 + (size_t)(R0 + n) * K + k0 + 8 * c) = o8; } }
    asm volatile("s_waitcnt lgkmcnt(0)" ::: "memory");
}
__device__ __forceinline__ void conv_item8(const float* src, int ld, int col4, const float* gain, unsigned char* dst8, int R0, int k0, LAS float* scr, int lane) {
    const int kr = lane >> 3, c4 = lane & 7;
    f32x4 v[8];
#pragma unroll
    for (int i = 0; i < 8; ++i) v[i] = __builtin_nontemporal_load((const f32x4*)(src + (size_t)(k0 + 8 * i + kr) * ld + col4));
#pragma unroll
    for (int i = 0; i < 8; ++i) { const float gk = gain[k0 + 8 * i + kr] * W8_SCALE; LAS float* sp = scr + (8 * i + kr) * 33 + 4 * c4; sp[0] = v[i][0] * gk; sp[1] = v[i][1] * gk; sp[2] = v[i][2] * gk; sp[3] = v[i][3] * gk; }
    asm volatile("s_waitcnt lgkmcnt(0)" ::: "memory");
    const int c = lane & 7;
#pragma unroll
    for (int j = 0; j < 4; ++j) { const int n = (lane >> 3) + 8 * j; const LAS float* sp = scr + (8 * c) * 33 + n;
        u32x2 o; o.x = pk4_fp8(sp[0 * 33], sp[1 * 33], sp[2 * 33], sp[3 * 33]); o.y = pk4_fp8(sp[4 * 33], sp[5 * 33], sp[6 * 33], sp[7 * 33]);
        *(u32x2*)(dst8 + (size_t)(R0 + n) * 2048 + k0 + 8 * c) = o; }
    asm volatile("s_waitcnt lgkmcnt(0)" ::: "memory");
}
__device__ __forceinline__ void p_prologue(Ctx& C) {
    LAS float* scr = (LAS float*)(C.lds + C.wave * 8448);
    const int gw = C.bid * 8 + C.wave, NGW = C.G * 8, lane = C.lane, c4 = lane & 7;
    constexpr int I_GU = 32 * 352, I_D = 88 * 64, I_IN = 32 * 512, I_B = 4 * 8 * 64, I_O = 32 * 64, I_L = 2 * I_GU + 2 * I_D + I_IN + I_B + I_O;
    constexpr int NITEMS = 2 * I_L + 64;
    for (int it = gw; it < NITEMS; it += NGW) {
        if (it >= 2 * I_L) {
            const int x = it - 2 * I_L, mt = x >> 3, y = x & 7, kb = y >> 2, nb = y & 3;
            conv_item(C.a->in[17] + (size_t)mt * 16384, 128, nb * 32 + 4 * c4, nullptr, WSP(bf16_t, WS_WPT) + (size_t)mt * 16384, 128, nb * 32, kb * 64, scr, lane); continue; }
        const int l = it / I_L; int r = it % I_L; unsigned char* wl = C.ws + WS_W + (size_t)l * W_LAYER;
        if (r < 2 * I_GU) {
            const int second = r >= I_GU; if (second) r -= I_GU;
            const int kb = r / 352, nb = r % 352, R0 = nb * 32, hid = (R0 >> 8) * 128 + (R0 & 127), isup = (R0 >> 7) & 1;
            const float* src = (second ? (isup ? C.a->in[24] : C.a->in[23]) : (isup ? C.a->in[10] : C.a->in[9])) + (size_t)l * DM * DFF; const float* gain = (second ? C.a->in[22] : C.a->in[8]) + l * DM;
            conv_item(src, DFF, hid + 4 * c4, gain, (bf16_t*)(wl + (second ? WL_GU2 : WL_GU1)), DM, R0, kb * 64, scr, lane); continue; }
        r -= 2 * I_GU;
        if (r < 2 * I_D) { const int second = r >= I_D; if (second) r -= I_D; const int kb = r / 64, nb = r % 64;
            conv_item((second ? C.a->in[25] : C.a->in[11]) + (size_t)l * DFF * DM, DM, nb * 32 + 4 * c4, nullptr, ((D8_MASK >> (2 * l + second)) & 1) ? (bf16_t*)nullptr : (bf16_t*)(wl + (second ? WL_D2 : WL_D1)), DFF, nb * 32, kb * 64, scr, lane,
                      ((D8_MASK >> (2 * l + second)) & 1) ? C.ws + WS_WD8 + (size_t)(2 * l + second) * (12u << 20) : nullptr); continue; }
        r -= 2 * I_D;
        if (r < I_IN) { const int kb = r / 512, nb = r % 512, R0 = nb * 32; int col = R0 + 4 * c4;
            if (R0 >= 6144 && R0 < 7168) { const int hb = R0 & ~127, wc = (R0 & 127) >> 5, fq = c4 >> 1, n = c4 & 1; col = hb + 16 * wc + 4 * fq + 64 * n; }
            if (R0 >= 8192) { const int d = R0 - 8192, pg = d >> 8, bj = (d >> 7) & 1, wc = (d >> 5) & 3, fq = c4 >> 1, n = c4 & 1;
                col = 8192 + (2 * bj + n) * 2048 + 64 * pg + 16 * wc + 4 * fq; }
            if (R0 < 1536 || R0 >= 8192) conv_item8(C.a->in[13] + (size_t)l * DM * INW, INW, col, C.a->in[12] + l * DM, wl + WL_IN + W8_OFF, R0 < 1536 ? R0 : R0 - 8192 + 1536, kb * 64, scr, lane);
            else conv_item(C.a->in[13] + (size_t)l * DM * INW, INW, col, C.a->in[12] + l * DM, (bf16_t*)(wl + WL_IN), DM, R0, kb * 64, scr, lane);
            continue; }
        r -= I_IN;
        if (r < I_B) { const int n = r / 512, y = r % 512, kb = y / 64, nb = y % 64;
            conv_item(C.a->in[20] + ((size_t)l * 4 + n) * 512 * DM, DM, nb * 32 + 4 * c4, nullptr, (bf16_t*)(wl + WL_B) + (size_t)n * DM * 512, 512, nb * 32, kb * 64, scr, lane); continue; }
        r -= I_B;
        { const int kb = r / 64, nb = r % 64;
          conv_item(C.a->in[21] + (size_t)l * DM * DM, DM, nb * 32 + 4 * c4, nullptr, (bf16_t*)(wl + WL_O), DM, nb * 32, kb * 64, scr, lane); }
    }
    float* X = WSP(float, WS_X); bf16_t* XB = WSP(bf16_t, WS_XB); u64* ss0 = C.ssbase;
    for (int row = gw; row < MR; row += NGW) {
        const float* src = row < MP ? C.a->in[0] + (size_t)row * DM : C.a->in[1] + (size_t)(row - MP) * DM;
        float s = 0.f;
#pragma unroll
        for (int j = 0; j < 8; ++j) { const f32x4 v = *(const f32x4*)(src + j * 256 + lane * 4); if (row >= MP) *(f32x4*)(X + (size_t)row * DM + j * 256 + lane * 4) = v;
            u32x2 w; w.x = pk2(v[0], v[1]); w.y = pk2(v[2], v[3]); *(u32x2*)(XB + (size_t)row * DM + j * 256 + lane * 4) = w; s += (v[0] * v[0] + v[1] * v[1]) + (v[2] * v[2] + v[3] * v[3]); }
        s = wave_sum(s); if (lane == 0) ss0[row] = ss_fix(s);
    }
    float* ROT = WSP(float, WS_ROT);
    for (int i = C.bid * 512 + C.tid; i < 2052 * 64; i += C.G * 512) {
        const int p = i >> 6, j = i & 63; const double pos = p < 2048 ? (double)p : (double)(8192 + p - 2048);
        double inv = 1.0; for (int q = 0; q < j; ++q) inv *= 0.86596432336006535;
        const double ang = pos * inv, n = __builtin_rint(ang * 0.15915494309189535);
        double rr = __builtin_fma(-n, 6.283185307179586, ang); rr = __builtin_fma(-n, 2.4492935982947064e-16, rr);
        const double h = 0.5 * rr, h2 = h * h;
        double sp = 1.0 / 51090942171709440000.0, cp = 1.0 / 1124000727777607680000.0;
        sp = sp * h2 - 1.0 / 121645100408832000.0; sp = sp * h2 + 1.0 / 355687428096000.0; sp = sp * h2 - 1.0 / 1307674368000.0; sp = sp * h2 + 1.0 / 6227020800.0; sp = sp * h2 - 1.0 / 39916800.0;
        sp = sp * h2 + 1.0 / 362880.0; sp = sp * h2 - 1.0 / 5040.0; sp = sp * h2 + 1.0 / 120.0; sp = sp * h2 - 1.0 / 6.0; sp = sp * h2 + 1.0; sp *= h;
        cp = -cp * h2 + 1.0 / 2432902008176640000.0; cp = cp * h2 - 1.0 / 6402373705728000.0; cp = cp * h2 + 1.0 / 20922789888000.0; cp = cp * h2 - 1.0 / 87178291200.0; cp = cp * h2 + 1.0 / 479001600.0;
        cp = cp * h2 - 1.0 / 3628800.0; cp = cp * h2 + 1.0 / 40320.0; cp = cp * h2 - 1.0 / 720.0; cp = cp * h2 + 1.0 / 24.0; cp = cp * h2 - 0.5; cp = cp * h2 + 1.0;
        ROT[2 * i] = (float)(1.0 - 2.0 * sp * sp); ROT[2 * i + 1] = (float)(2.0 * sp * cp);
    }
}

template <int NB, int KS>
__device__ __forceinline__ void wave_gemm_nt(const LAS unsigned char* A, const LAS unsigned char* BT, f32x4 (&acc)[NB], int lane) {
    const int r = lane & 15, q = lane >> 4;
#pragma unroll
    for (int ks = 0; ks < KS; ++ks) {
        const bf16x8 a = *(const LAS bf16x8*)(A + r * TS_ + ks * 64 + q * 16);
#pragma unroll
        for (int nb = 0; nb < NB; ++nb) { const bf16x8 b = *(const LAS bf16x8*)(BT + (nb * 16 + r) * TS_ + ks * 64 + q * 16); acc[nb] = __builtin_amdgcn_mfma_f32_16x16x32_bf16(b, a, acc[nb], 0, 0, 0); }
    }
}
template <int NB, int KS>
__device__ __forceinline__ void wave_gemm_nt_areg(const bf16x8 (&af)[KS], const LAS unsigned char* BT, f32x4 (&acc)[NB], int lane) {
    const int r = lane & 15, q = lane >> 4;
#pragma unroll
    for (int ks = 0; ks < KS; ++ks) {
#pragma unroll
        for (int nb = 0; nb < NB; ++nb) { const bf16x8 b = *(const LAS bf16x8*)(BT + (nb * 16 + r) * TS_ + ks * 64 + q * 16); acc[nb] = __builtin_amdgcn_mfma_f32_16x16x32_bf16(b, af[ks], acc[nb], 0, 0, 0); }
    }
}
__device__ __forceinline__ void tile_load_nat(LAS unsigned char* dst, const bf16_t* src, size_t row0, int rstride, int ld, int tid) {
#pragma unroll
    for (int it = 0; it < 4; ++it) { const int idx = tid + it * 512, i = idx >> 4, ch = idx & 15;
        const u32x4 v = *(const u32x4*)(src + (row0 + (size_t)i * rstride) * ld + ch * 8); *(LAS u32x4*)(dst + i * TS_ + ch * 16) = v; }
}
template <bool SCALE>
__device__ __forceinline__ void tile_load_T(LAS unsigned char* dst, const bf16_t* src, size_t row0, int rstride, int ld, int tid, float rowscale) {
    const int i = tid & 127, cq = tid >> 7;
#pragma unroll
    for (int it = 0; it < 4; ++it) { const int ch = cq + 4 * it;
        const u32x4 v = *(const u32x4*)(src + (row0 + (size_t)i * rstride) * ld + ch * 8);
        const unsigned w[4] = {v.x, v.y, v.z, v.w};
#pragma unroll
        for (int e = 0; e < 4; ++e) { unsigned lo = w[e] & 0xffffu, hi = w[e] >> 16;
            if (SCALE) { const unsigned p = pk2(bf2f(lo) * rowscale, bf2f(hi) * rowscale); lo = p & 0xffffu; hi = p >> 16; }
            *(LAS bf16_t*)(dst + (ch * 8 + 2 * e) * TS_ + i * 2) = (bf16_t)lo; *(LAS bf16_t*)(dst + (ch * 8 + 2 * e + 1) * TS_ + i * 2) = (bf16_t)hi; }
    }
}
__device__ __forceinline__ void store_p_rows(LAS unsigned char* P, const f32x4 (&p)[8], int lane) {
    const int r = lane & 15, q = lane >> 4;
#pragma unroll
    for (int nb = 0; nb < 8; ++nb) { u32x2 w; w.x = pk2(p[nb][0], p[nb][1]); w.y = pk2(p[nb][2], p[nb][3]); *(LAS u32x2*)(P + r * TS_ + (nb * 16 + 4 * q) * 2) = w; }
}

__device__ __forceinline__ void attn_unit(Ctx& C, int b, int g, int h, int r, int qb) {
    const int tid = C.tid, lane = C.lane, wave = C.wave, q4 = lane >> 4, dil = 1 << (2 * g);
    LAS unsigned char* Ks = C.lds; LAS unsigned char* VT = C.lds + TILE; LAS unsigned char* Ps = C.lds + 2 * TILE + wave * 16 * TS_; LAS float* biasL = (LAS float*)(C.lds + 3 * TILE);
    const bf16_t* QKV = WSP(bf16_t, WS_QKV);
    __syncthreads();
    if (tid < 129) biasL[tid] = C.a->in[7][BUCKET[g][tid] * 12 + g * 4 + h] * LOG2E;
    const int iq = wave * 16 + (lane & 15); const size_t qrow = (size_t)b * 2048 + r + dil * (128 * qb + iq);
    bf16x8 qf[4];
#pragma unroll
    for (int ks = 0; ks < 4; ++ks) qf[ks] = *(const bf16x8*)(QKV + qrow * 4608 + g * 512 + h * 128 + ks * 32 + q4 * 8);
    float mrun = -INFINITY, lrun = 0.f; f32x4 o[8];
#pragma unroll
    for (int nb = 0; nb < 8; ++nb) o[nb] = (f32x4){0.f, 0.f, 0.f, 0.f};
    const int kb0 = qb > 0 ? qb - 1 : 0;
    for (int kb = kb0; kb <= qb; ++kb) {
        if (kb != kb0) __syncthreads();
        const size_t krow0 = (size_t)b * 2048 + r + (size_t)dil * 128 * kb;
        tile_load_nat(Ks, QKV + 1536 + g * 512 + h * 128, krow0, dil, 4608, tid);
        tile_load_T<false>(VT, QKV + 3072 + g * 512 + h * 128, krow0, dil, 4608, tid, 1.f);
        __syncthreads();
        f32x4 s[8];
#pragma unroll
        for (int nb = 0; nb < 8; ++nb) s[nb] = (f32x4){0.f, 0.f, 0.f, 0.f};
        wave_gemm_nt_areg<8, 4>(qf, Ks, s, lane);
        const int joff = 128 * (qb - kb) + iq; float mx = -INFINITY;
#pragma unroll
        for (int nb = 0; nb < 8; ++nb)
#pragma unroll
            for (int i = 0; i < 4; ++i) { const int j = joff - (nb * 16 + 4 * q4 + i); const bool ok = (j >= 0) && (j <= 128); const int jc = j < 0 ? 0 : (j > 128 ? 128 : j);
                const float val = ok ? s[nb][i] * ATT_SC + biasL[jc] : -INFINITY; s[nb][i] = val; mx = fmaxf(mx, val); }
        mx = fmaxf(mx, __shfl_xor(mx, 16)); mx = fmaxf(mx, __shfl_xor(mx, 32));
        const float mn = fmaxf(mrun, mx), alpha = (mrun == -INFINITY) ? 0.f : fexp2(mrun - mn); float rs = 0.f;
#pragma unroll
        for (int nb = 0; nb < 8; ++nb)
#pragma unroll
            for (int i = 0; i < 4; ++i) { const float p = (s[nb][i] == -INFINITY) ? 0.f : fexp2(s[nb][i] - mn); s[nb][i] = p; rs += p; }
        rs += __shfl_xor(rs, 16); rs += __shfl_xor(rs, 32);
        lrun = lrun * alpha + rs; mrun = mn;
#pragma unroll
        for (int nb = 0; nb < 8; ++nb) o[nb] *= alpha;
        store_p_rows(Ps, s, lane);
        wave_gemm_nt<8, 4>(Ps, VT, o, lane);
    }
    const float inv = 1.0f / lrun;
    bf16_t* AO = WSP(bf16_t, WS_AO) + ((size_t)g * MPAD + qrow) * 512 + h * 128;
#pragma unroll
    for (int nb = 0; nb < 8; ++nb) { u32x2 w; w.x = pk2(o[nb][0] * inv, o[nb][1] * inv); w.y = pk2(o[nb][2] * inv, o[nb][3] * inv); *(u32x2*)(AO + nb * 16 + 4 * q4) = w; }
    if (q4 == 0) WSP(float, WS_LSE)[((size_t)g * MPAD + qrow) * 4 + h] = mrun + __log2f(lrun);
}
__device__ __forceinline__ void attn_sample_item(Ctx& C, int layer, int it) {
    const int lane = C.lane, wave = C.wave;
    LAS float* wl = (LAS float*)(C.lds + wave * 2048); LAS float* ql = wl; LAS float* pl = wl + 128; LAS float* ol = wl + 264;
    const bf16_t* QKV = WSP(bf16_t, WS_QKV);
    const int tr = it * 2 + (wave >= 3 ? 1 : 0), g = wave % 3, b = tr >> 4, s = (tr >> 2) & 3, h = tr & 3;
    if (wave < 6) {
        const size_t row = MP + b * 4 + s; const int win = 128 << (2 * g), dil = 1 << (2 * g);
        const float* cache = (g == 0 ? C.a->in[2] : (g == 1 ? C.a->in[3] : C.a->in[4])) + (size_t)(layer * 32 + b) * win * 1024 + h * 128;
        { const unsigned w = *(const unsigned*)(QKV + row * 4608 + g * 512 + h * 128 + 2 * lane); ql[2 * lane] = bflo(w); ql[2 * lane + 1] = bfhi(w); }
        asm volatile("s_waitcnt lgkmcnt(0)" ::: "memory");
        float sc[3];
#pragma unroll
        for (int jj = 0; jj < 3; ++jj) {
            const int j = lane + 64 * jj; float d = -INFINITY;
            if (j <= 128) {
                const int idx = win + s - j * dil; d = 0.f;
                if (idx >= win) { const bf16_t* kp = QKV + (size_t)(MP + b * 4 + idx - win) * 4608 + 1536 + g * 512 + h * 128;
                    u32x4 kw[16];
#pragma unroll
                    for (int c = 0; c < 16; ++c) kw[c] = *(const u32x4*)(kp + c * 8);
#pragma unroll
                    for (int c = 0; c < 16; ++c) { const f32x4 qa = *(const LAS f32x4*)(ql + c * 8), qb_ = *(const LAS f32x4*)(ql + c * 8 + 4);
                        d += qa[0] * bflo(kw[c].x) + qa[1] * bfhi(kw[c].x) + qa[2] * bflo(kw[c].y) + qa[3] * bfhi(kw[c].y) + qb_[0] * bflo(kw[c].z) + qb_[1] * bfhi(kw[c].z) + qb_[2] * bflo(kw[c].w) + qb_[3] * bfhi(kw[c].w); } }
                else { const float* kp = cache + (size_t)idx * 1024;
#pragma unroll
                    for (int c0 = 0; c0 < 32; c0 += 16) { f32x4 kw[16];
#pragma unroll
                        for (int c = 0; c < 16; ++c) kw[c] = *(const f32x4*)(kp + (c0 + c) * 4);
#pragma unroll
                        for (int c = 0; c < 16; ++c) { const f32x4 qa = *(const LAS f32x4*)(ql + (c0 + c) * 4); d += qa[0] * kw[c][0] + qa[1] * kw[c][1] + qa[2] * kw[c][2] + qa[3] * kw[c][3]; } } }
                d = d * ATT_SC + C.a->in[7][BUCKET[g][j] * 12 + g * 4 + h] * LOG2E;
            }
            sc[jj] = d;
        }
        const float mx = wave_max(fmaxf(sc[0], fmaxf(sc[1], sc[2]))); float sum = 0.f;
#pragma unroll
        for (int jj = 0; jj < 3; ++jj) { const int j = lane + 64 * jj; if (j <= 128) { const float p = fexp2(sc[jj] - mx); sum += p; pl[j] = p; } }
        sum = wave_sum(sum);
        asm volatile("s_waitcnt lgkmcnt(0)" ::: "memory");
        float a0 = 0.f, a1 = 0.f;
        for (int j = 0; j < 4; ++j) {
            const float p = pl[j]; const int idx = win + s - j * dil;
            if (idx >= win) { const unsigned w = *(const unsigned*)(QKV + (size_t)(MP + b * 4 + idx - win) * 4608 + 3072 + g * 512 + h * 128 + 2 * lane); a0 += p * bflo(w); a1 += p * bfhi(w); }
            else { const f32x2v vv = *(const f32x2v*)(cache + (size_t)idx * 1024 + 512 + 2 * lane); a0 += p * vv[0]; a1 += p * vv[1]; }
        }
        const float* vbase = cache + (size_t)(win + s) * 1024 + 512 + 2 * lane;
        for (int j0 = 4; j0 <= 128; j0 += 25) {
            f32x2v vv[25];
#pragma unroll
            for (int k = 0; k < 25; ++k) vv[k] = *(const f32x2v*)(vbase - (size_t)(j0 + k) * dil * 1024);
#pragma unroll
            for (int k = 0; k < 25; ++k) { const float p = pl[j0 + k]; a0 += p * vv[k][0]; a1 += p * vv[k][1]; }
        }
        ol[2 + 2 * lane] = a0; ol[3 + 2 * lane] = a1; if (lane == 0) { ol[0] = mx; ol[1] = sum; }
    }
    __syncthreads();
    if (wave == 0 || wave == 3) {
        const LAS float* o0 = (const LAS float*)(C.lds + wave * 2048) + 264; const LAS float* o1 = o0 + 512; const LAS float* o2 = o0 + 1024;
        const float m0 = o0[0], m1 = o1[0], m2 = o2[0], M = fmaxf(m0, fmaxf(m1, m2)), w0 = fexp2(m0 - M), w1 = fexp2(m1 - M), w2 = fexp2(m2 - M);
        const float inv = 1.0f / (w0 * o0[1] + w1 * o1[1] + w2 * o2[1]);
        const float r0 = (w0 * o0[2 + 2 * lane] + w1 * o1[2 + 2 * lane] + w2 * o2[2 + 2 * lane]) * inv, r1 = (w0 * o0[3 + 2 * lane] + w1 * o1[3 + 2 * lane] + w2 * o2[3 + 2 * lane]) * inv;
        *(unsigned*)(WSP(bf16_t, WS_BR) + (size_t)(MP + b * 4 + s) * 512 + h * 128 + 2 * lane) = pk2(r0, r1);
    }
}
__device__ __forceinline__ void gmlp_unit(Ctx& C, int layer, int b, int n, int g) {
    const int tid = C.tid, lane = C.lane, wave = C.wave, q4 = lane >> 4;
    LAS unsigned char* A = C.lds; LAS unsigned char* VT = C.lds + TILE;
    const size_t row0 = (size_t)b * 2048 + 128 * n;
    __syncthreads();
    { const int t = tid >> 2, sq = (tid & 3) * 32; const float* wp = C.a->in[15] + ((size_t)(layer * 4 + g) * 128 + t) * 128 + sq;
#pragma unroll
      for (int k = 0; k < 4; ++k) { const f32x4 a = *(const f32x4*)(wp + 8 * k), bq = *(const f32x4*)(wp + 8 * k + 4); float x[8] = {a[0], a[1], a[2], a[3], bq[0], bq[1], bq[2], bq[3]};
#pragma unroll
          for (int e = 0; e < 8; ++e) if (sq + 8 * k + e > t) x[e] = 0.f;
          u32x4 w; w.x = pk2(x[0], x[1]); w.y = pk2(x[2], x[3]); w.z = pk2(x[4], x[5]); w.w = pk2(x[6], x[7]); *(LAS u32x4*)(A + t * TS_ + (sq + 8 * k) * 2) = w; } }
    { const int i = tid & 127, cq = tid >> 7; const u64* ssv = C.ssbase + (7 + layer) * MPAD; const float rstd = rsqrtf(ss_get(ssv + row0 + i) * (1.0f / 512) + EPS);
      const float* bv = WSP(float, WS_BV) + (row0 + i) * 512 + g * 128; const float* gg = C.a->in[14] + layer * 512 + g * 128;
#pragma unroll
      for (int it = 0; it < 8; ++it) { const int c0 = (cq + 4 * it) * 4; const f32x4 v = *(const f32x4*)(bv + c0), gv = *(const f32x4*)(gg + c0);
#pragma unroll
          for (int e = 0; e < 4; ++e) *(LAS bf16_t*)(VT + (c0 + e) * TS_ + i * 2) = f2bf(v[e] * rstd * gv[e]); } }
    __syncthreads();
    f32x4 acc[8];
#pragma unroll
    for (int nb = 0; nb < 8; ++nb) acc[nb] = (f32x4){0.f, 0.f, 0.f, 0.f};
    wave_gemm_nt<8, 4>(A + wave * 16 * TS_, VT, acc, lane);
    const int t = wave * 16 + (lane & 15); const float bs = C.a->in[16][(layer * 4 + g) * 128 + t]; const size_t row = row0 + t;
    const bf16_t* bu = WSP(bf16_t, WS_BU) + row * 512 + g * 128; bf16_t* br = WSP(bf16_t, WS_BR) + ((size_t)1 * MPAD + row) * 512 + g * 128;
#pragma unroll
    for (int nb = 0; nb < 8; ++nb) { const int c = nb * 16 + 4 * q4; const u32x2 uw = *(const u32x2*)(bu + c);
        u32x2 w; w.x = pk2(bflo(uw.x) * (acc[nb][0] + bs), bfhi(uw.x) * (acc[nb][1] + bs)); w.y = pk2(bflo(uw.y) * (acc[nb][2] + bs), bfhi(uw.y) * (acc[nb][3] + bs)); *(u32x2*)(br + c) = w; }
}
__device__ __forceinline__ void gmlp_sample_item(Ctx& C, int layer, int b) {
    const int c = C.tid, g = c >> 7; const u64* ssv = C.ssbase + (7 + layer) * MPAD; const float gg = C.a->in[14][layer * 512 + c];
    float vn[4];
#pragma unroll
    for (int t = 0; t < 4; ++t) { const size_t row = MP + b * 4 + t; vn[t] = WSP(float, WS_BV)[row * 512 + c] * rsqrtf(ss_get(ssv + row) * (1.0f / 512) + EPS) * gg;
        C.out[O_GVS + ((size_t)(layer * 32 + b) * 4 + t) * 512 + c] = vn[t]; }
#pragma unroll
    for (int t = 0; t < 4; ++t) { float mx = C.a->in[16][(layer * 4 + g) * 128 + t];
#pragma unroll
        for (int s = 0; s < 4; ++s) if (s <= t) mx += C.a->in[15][((size_t)(layer * 4 + g) * 128 + t) * 128 + s] * vn[s];
        const size_t row = MP + b * 4 + t; WSP(bf16_t, WS_BR)[((size_t)1 * MPAD + row) * 512 + c] = f2bf(bf2f(WSP(bf16_t, WS_BU)[row * 512 + c]) * mx); }
}
template <int NB, int KS>
__device__ __forceinline__ void wave_gemm_nt_bglobal(const LAS unsigned char* A, const bf16_t* BTg  , f32x4 (&acc)[NB], int lane) {
    const int r = lane & 15, q = lane >> 4;
#pragma unroll
    for (int ks = 0; ks < KS; ++ks) {
        const bf16x8 a = *(const LAS bf16x8*)(A + r * TS_ + ks * 64 + q * 16);
#pragma unroll
        for (int nb = 0; nb < NB; ++nb) { const bf16x8 b = *(const bf16x8*)(BTg + (nb * 16 + r) * (32 * KS) + ks * 32 + q * 8); acc[nb] = __builtin_amdgcn_mfma_f32_16x16x32_bf16(b, a, acc[nb], 0, 0, 0); }
    }
}
__device__ __forceinline__ void pool_unit(Ctx& C, int layer, int rb, int g) {
    const int tid = C.tid, lane = C.lane, wave = C.wave, q4 = lane >> 4, win = 2 << g;
    LAS float* EXT = (LAS float*)C.lds; LAS unsigned char* A = C.lds + 73728;
    const float* CIN = WSP(float, WS_CIN);
    __syncthreads();
    const int c = tid & 127, tq = tid >> 7, col = g * 128 + c;
    if (rb < 64) {
        const int bt0 = (rb & 15) * 128; const float* base = CIN + (size_t)(rb >> 4) * 2048 * 512 + g * 128;
#pragma unroll
        for (int k = 0; k < 9; ++k) { const int idx = tid + 512 * k, row = idx >> 5, ch = idx & 31;
            if (row < 143) { const int tt = bt0 - 15 + row; f32x4 v = (f32x4){0.f, 0.f, 0.f, 0.f}; if (tt >= 0) v = *(const f32x4*)(base + (size_t)tt * 512 + ch * 4); *(LAS f32x4*)(EXT + row * 128 + ch * 4) = v; } }
        __syncthreads();
        float wsum = 0.f;
        for (int i = 1; i < win; ++i) wsum += EXT[(15 + 32 * tq - i) * 128 + c];
#pragma unroll 4
        for (int k = 0; k < 32; ++k) { const int r = 32 * tq + k, t = bt0 + r; const float xv = EXT[(15 + r) * 128 + c]; wsum += xv; const int cnt = (t + 1) < win ? (t + 1) : win;
            *(LAS bf16_t*)(A + r * TS_ + c * 2) = f2bf(wsum / (float)cnt - xv); wsum -= EXT[(15 + r - win + 1) * 128 + c]; }
    } else {
        const float* sp = C.a->in[5];
        for (int bb = 0; bb < 8; ++bb) { const int b = 8 * tq + bb; const float* st = sp + (size_t)(layer * 32 + b) * 15 * 512 + col; const float* nw = CIN + (size_t)(MP + b * 4) * 512 + col;
            float e[19];
#pragma unroll
            for (int i = 0; i < 15; ++i) e[i] = st[(size_t)i * 512];
#pragma unroll
            for (int i = 0; i < 4; ++i) e[15 + i] = nw[(size_t)i * 512];
#pragma unroll
            for (int s = 0; s < 4; ++s) { float wsum = 0.f;
#pragma unroll
                for (int i = 0; i < 16; ++i) if (i < win) wsum += e[15 + s - i];
                *(LAS bf16_t*)(A + (b * 4 + s) * TS_ + c * 2) = f2bf(wsum / (float)win - e[15 + s]); }
#pragma unroll
            for (int i = 0; i < 11; ++i) C.out[O_POOLS + ((size_t)(layer * 32 + b) * 15 + i) * 512 + col] = e[i + 4]; }
    }
    __syncthreads();
    f32x4 acc[8];
#pragma unroll
    for (int nb = 0; nb < 8; ++nb) acc[nb] = (f32x4){0.f, 0.f, 0.f, 0.f};
    wave_gemm_nt_bglobal<8, 4>(A + wave * 16 * TS_, WSP(bf16_t, WS_WPT) + (size_t)(layer * 4 + g) * 16384, acc, lane);
    const size_t row = (size_t)rb * 128 + wave * 16 + (lane & 15); const float* ps = C.a->in[18] + layer * 512 + g * 128; bf16_t* br = WSP(bf16_t, WS_BR) + ((size_t)2 * MPAD + row) * 512 + g * 128;
#pragma unroll
    for (int nb = 0; nb < 8; ++nb) { const int d = nb * 16 + 4 * q4; const f32x4 sc = *(const f32x4*)(ps + d);
        u32x2 w; w.x = pk2(acc[nb][0] * sc[0], acc[nb][1] * sc[1]); w.y = pk2(acc[nb][2] * sc[2], acc[nb][3] * sc[3]); *(u32x2*)(br + d) = w; }
}
__device__ __forceinline__ void retloc_unit(Ctx& C, int b, int h, int c) {
    const int tid = C.tid, lane = C.lane, wave = C.wave, q4 = lane >> 4;
    LAS unsigned char* KT = C.lds; LAS unsigned char* VT = C.lds + TILE;
    const bf16_t* DR = WSP(bf16_t, WS_DR); const size_t row0 = (size_t)b * 2048 + 128 * c; const float lg = lg2gamma(h);
    __syncthreads();
    tile_load_T<true>(KT, DR + 512 + h * 128, row0, 1, 2048, tid, exp2f((float)(127 - (tid & 127)) * lg));
    tile_load_T<false>(VT, DR + 1024 + h * 128, row0, 1, 2048, tid, 1.f);
    __syncthreads();
    f32x4 acc[8];
#pragma unroll
    for (int nb = 0; nb < 8; ++nb) acc[nb] = (f32x4){0.f, 0.f, 0.f, 0.f};
    wave_gemm_nt<8, 4>(KT + wave * 16 * TS_, VT, acc, lane);
    float* loc = WSP(float, WS_LOC) + ((size_t)(b * 4 + h) * 16 + c) * 16384 + (wave * 16 + (lane & 15)) * 128;
#pragma unroll
    for (int nb = 0; nb < 8; ++nb) *(f32x4*)(loc + nb * 16 + 4 * q4) = acc[nb];
}
__device__ __forceinline__ void ret_sample_item(Ctx& C, int layer, int b, int h) {
    const int tid = C.tid, e = tid & 127, dq = tid >> 7;
    LAS float* qs = (LAS float*)C.lds; LAS float* ks = qs + 512; LAS float* vs = ks + 512; LAS float* qk = vs + 512; LAS float* red = qk + 16; LAS float* nrm = red + 2048;
    const bf16_t* DR = WSP(bf16_t, WS_DR); const float lg = lg2gamma(h);
    __syncthreads();
    for (int i = tid; i < 1536; i += 512) { const int which = i >> 9, t = (i >> 7) & 3, d = i & 127; qs[i] = bf2f(DR[(size_t)(MP + b * 4 + t) * 2048 + which * 512 + h * 128 + d]); }
    __syncthreads();
    if (tid < 16) { const int t = tid >> 2, s = tid & 3; float d = 0.f; for (int k = 0; k < 128; ++k) d += qs[t * 128 + k] * ks[s * 128 + k]; qk[tid] = d; }
    const float* S0 = C.a->in[6] + ((size_t)(layer * 32 + b) * 4 + h) * 16384; float* Sn = C.out + O_RETS + ((size_t)(layer * 32 + b) * 4 + h) * 16384;
    const float g1 = exp2f(lg), g2 = g1 * g1, g3 = g2 * g1, g4 = g2 * g2;
    float a0 = 0.f, a1 = 0.f, a2 = 0.f, a3 = 0.f; const float v0 = vs[e], v1 = vs[128 + e], v2 = vs[256 + e], v3 = vs[384 + e];
    for (int k0 = 0; k0 < 32; k0 += 16) { float sv[16];
#pragma unroll
        for (int k = 0; k < 16; ++k) sv[k] = S0[(32 * dq + k0 + k) * 128 + e];
#pragma unroll
        for (int k = 0; k < 16; ++k) { const int d = 32 * dq + k0 + k; const float s0 = sv[k];
            a0 += qs[d] * s0; a1 += qs[128 + d] * s0; a2 += qs[256 + d] * s0; a3 += qs[384 + d] * s0;
            Sn[d * 128 + e] = g4 * s0 + g3 * ks[d] * v0 + g2 * ks[128 + d] * v1 + g1 * ks[256 + d] * v2 + ks[384 + d] * v3; } }
    red[(dq * 4 + 0) * 128 + e] = a0; red[(dq * 4 + 1) * 128 + e] = a1; red[(dq * 4 + 2) * 128 + e] = a2; red[(dq * 4 + 3) * 128 + e] = a3;
    __syncthreads();
    const int t = dq; float o = (red[(0 * 4 + t) * 128 + e] + red[(1 * 4 + t) * 128 + e] + red[(2 * 4 + t) * 128 + e] + red[(3 * 4 + t) * 128 + e]) * exp2f((float)(t + 1) * lg);
    for (int s = 0; s <= t; ++s) o += exp2f((float)(t - s) * lg) * qk[t * 4 + s] * vs[s * 128 + e];
    const float sq = wave_sum(o * o); if (C.lane == 0) nrm[C.wave] = sq;
    __syncthreads();
    const float ms = (nrm[2 * t] + nrm[2 * t + 1]) * (1.0f / 128);
    const size_t row = MP + b * 4 + t;
    WSP(bf16_t, WS_BR)[((size_t)3 * MPAD + row) * 512 + h * 128 + e] = f2bf(o * rsqrtf(ms + EPS) * C.a->in[19][layer * 512 + h * 128 + e] * bf2f(DR[row * 2048 + 1536 + h * 128 + e]));
}
__device__ __forceinline__ void p_mix1(Ctx& C, int layer) {
    const int G = C.G, bid = C.bid;
    for (int it = bid; it < 768; it += G) { const int g = it >> 8, rem = it & 255, bh = rem >> 4, x = rem & 15; attn_unit(C, bh >> 2, g, bh & 3, g == 0 ? 0 : (g == 1 ? (x >> 2) : x), g == 0 ? x : (g == 1 ? (x & 3) : 0)); }
    for (int it = bid; it < 256; it += G) retloc_unit(C, it >> 6, (it >> 4) & 3, it & 15);
#if FUSE_MIX
    asm volatile("s_waitcnt vmcnt(0)" ::: "memory");
    __syncthreads();
    if (C.tid == 0) { __builtin_amdgcn_fence(__ATOMIC_RELEASE, "agent"); asm volatile("s_waitcnt vmcnt(0)" ::: "memory"); (void)xb_add((unsigned*)(C.ws + WS_CTL) + CW_WQ + 128 + layer * 16 + (bid >> 4), 1u); }
#endif
    for (int it = bid; it < 256; it += G) gmlp_unit(C, layer, it >> 6, (it >> 2) & 15, it & 3);
    for (int it = bid; it < 260; it += G) pool_unit(C, layer, it >> 2, it & 3);
    for (int it = bid; it < 256; it += G) { __syncthreads(); attn_sample_item(C, layer, it); }
    for (int it = (bid + G - 68 % G) % G; it < 32; it += G) { __syncthreads(); gmlp_sample_item(C, layer, it); }
    for (int it = (bid + G - 100 % G) % G; it < 128; it += G) ret_sample_item(C, layer, it >> 2, it & 3);
    __syncthreads();
}
__device__ __forceinline__ void retout_unit(Ctx& C, int layer, int b, int h, int c) {
    const int tid = C.tid, lane = C.lane, wave = C.wave, q4 = lane >> 4;
    LAS unsigned char* Ks = C.lds; LAS unsigned char* VT = C.lds + TILE; LAS unsigned char* ST = C.lds + 2 * TILE;
    const bf16_t* DR = WSP(bf16_t, WS_DR); const size_t row0 = (size_t)b * 2048 + 128 * c; const float lg = lg2gamma(h), cd = exp2f(128.0f * lg);
    __syncthreads();
    {
        typedef float f32x2_t __attribute__((ext_vector_type(2)));
        float* SB = WSP(float, WS_G); const int bh = b * 4 + h; const size_t sl = (size_t)bh * 16 * 16384 + c * 1024 + tid * 2;
        const float* loc = WSP(float, WS_LOC) + sl; float* sb = SB + sl;
        f32x2_t v[16];
#pragma unroll
        for (int j = 0; j < 16; ++j) v[j] = *(const f32x2_t*)(loc + (size_t)j * 16384);
        f32x2_t s = (f32x2_t){0.f, 0.f};
#pragma unroll
        for (int j = 0; j < 15; ++j) { s = s * cd + v[j]; *(f32x2_t*)(sb + (size_t)(j + 1) * 16384) = s; }
        s = s * cd + v[15];
        *(f32x2_t*)(C.out + O_RETP + ((size_t)(layer * 4 + b) * 4 + h) * 16384 + c * 1024 + tid * 2) = s;
        asm volatile("s_waitcnt vmcnt(0)" ::: "memory");
        __syncthreads();
        if (tid == 0) {
            unsigned* bar = (unsigned*)(C.ws + WS_CTL) + CW_BAR; unsigned* flag = (unsigned*)(C.ws + WS_CTL) + CW_WQ + 16 + layer * 16 + bh;
            __builtin_amdgcn_fence(__ATOMIC_RELEASE, "agent"); asm volatile("s_waitcnt vmcnt(0)" ::: "memory");
            (void)xb_add(flag, 1u);
            if (c > 0) XB_SPIN(xb_ld(flag) < 16u, bar);
            __builtin_amdgcn_fence(__ATOMIC_ACQUIRE, "agent"); asm volatile("s_waitcnt vmcnt(0)" ::: "memory");
        }
        __syncthreads();
        const int d = tid >> 2, e0 = (tid & 3) * 32; const float* sc = SB + ((size_t)bh * 16 + c) * 16384 + d * 128 + e0;
#pragma unroll
        for (int k8 = 0; k8 < 8; ++k8) { f32x4 w = (f32x4){0.f, 0.f, 0.f, 0.f}; if (c > 0) w = *(const f32x4*)(sc + 4 * k8);
#pragma unroll
            for (int e = 0; e < 4; ++e) *(LAS bf16_t*)(ST + (e0 + 4 * k8 + e) * TS_ + d * 2) = f2bf(w[e]); } }
    tile_load_nat(Ks, DR + 512 + h * 128, row0, 1, 2048, tid);
    tile_load_T<false>(VT, DR + 1024 + h * 128, row0, 1, 2048, tid, 1.f);
    const int t = wave * 16 + (lane & 15); const size_t row = row0 + t;
    bf16x8 qf[4];
#pragma unroll
    for (int ks = 0; ks < 4; ++ks) qf[ks] = *(const bf16x8*)(DR + row * 2048 + h * 128 + ks * 32 + q4 * 8);
    __syncthreads();
    f32x4 o[8], a[8];
#pragma unroll
    for (int nb = 0; nb < 8; ++nb) { o[nb] = (f32x4){0.f, 0.f, 0.f, 0.f}; a[nb] = (f32x4){0.f, 0.f, 0.f, 0.f}; }
    if (c > 0) { wave_gemm_nt_areg<8, 4>(qf, ST, o, lane); const float qd = exp2f((float)(t + 1) * lg);
#pragma unroll
        for (int nb = 0; nb < 8; ++nb) o[nb] *= qd; }
    wave_gemm_nt_areg<8, 4>(qf, Ks, a, lane);
#pragma unroll
    for (int nb = 0; nb < 8; ++nb)
#pragma unroll
        for (int i = 0; i < 4; ++i) { const int s = nb * 16 + 4 * q4 + i; a[nb][i] = (s <= t) ? a[nb][i] * exp2f((float)(t - s) * lg) : 0.f; }
    __syncthreads();
    store_p_rows(Ks + wave * 16 * TS_, a, lane);
    wave_gemm_nt<8, 4>(Ks + wave * 16 * TS_, VT, o, lane);
    float ms = 0.f;
#pragma unroll
    for (int nb = 0; nb < 8; ++nb) ms += (o[nb][0] * o[nb][0] + o[nb][1] * o[nb][1]) + (o[nb][2] * o[nb][2] + o[nb][3] * o[nb][3]);
    ms += __shfl_xor(ms, 16); ms += __shfl_xor(ms, 32);
    const float rn = rsqrtf(ms * (1.0f / 128) + EPS); const float* gr = C.a->in[19] + layer * 512 + h * 128; const bf16_t* dg = DR + row * 2048 + 1536 + h * 128;
    bf16_t* br = WSP(bf16_t, WS_BR) + ((size_t)3 * MPAD + row) * 512 + h * 128;
#pragma unroll
    for (int nb = 0; nb < 8; ++nb) { const int e = nb * 16 + 4 * q4; const f32x4 g4 = *(const f32x4*)(gr + e); const u32x2 gw = *(const u32x2*)(dg + e);
        u32x2 w; w.x = pk2(o[nb][0] * rn * g4[0] * bflo(gw.x), o[nb][1] * rn * g4[1] * bfhi(gw.x)); w.y = pk2(o[nb][2] * rn * g4[2] * bflo(gw.y), o[nb][3] * rn * g4[3] * bfhi(gw.y)); *(u32x2*)(br + e) = w; }
}
__device__ __forceinline__ void p_mix2(Ctx& C, int layer) {
#if FUSE_MIX
    if (C.tid == 0) { unsigned* bar = (unsigned*)(C.ws + WS_CTL) + CW_BAR; unsigned* fa = (unsigned*)(C.ws + WS_CTL) + CW_WQ + 128 + layer * 16 + (C.bid >> 4);
        XB_SPIN(xb_ld(fa) < 16u, bar); __builtin_amdgcn_fence(__ATOMIC_ACQUIRE, "agent"); asm volatile("s_waitcnt vmcnt(0)" ::: "memory"); }
    __syncthreads();
#endif
    for (int it = C.bid; it < 256; it += C.G) retout_unit(C, layer, it >> 6, (it >> 4) & 3, it & 15);
    const bf16_t* AO = WSP(bf16_t, WS_AO); const float* LSE = WSP(float, WS_LSE); bf16_t* br = WSP(bf16_t, WS_BR);
#if FUSE_MIX
    for (int k = 0; k < 4; ++k) {
        const int il = (C.bid & 15) * 2048 + k * 512 + C.tid, bh = C.bid >> 4;
        const int row = (bh >> 2) * 2048 + (il >> 4), h = bh & 3, ch = il & 15;
#else
    unsigned* wq = (unsigned*)(C.ws + WS_CTL) + CW_WQ + layer; volatile LAS unsigned* slot = (volatile LAS unsigned*)(C.lds + MISC_OFF) + 12;
    for (;;) {
        __syncthreads();
        if (C.tid == 0) *slot = __hip_atomic_fetch_add(wq, 1u, __ATOMIC_RELAXED, __HIP_MEMORY_SCOPE_AGENT);
        __syncthreads();
        const unsigned chunk = *slot; if (chunk >= (unsigned)(MP * 64 / 512)) break;
        const int idx = (int)chunk * 512 + C.tid;
        const int row = idx >> 6, h = (idx >> 4) & 3, ch = idx & 15;
#endif
        const float l0 = LSE[((size_t)0 * MPAD + row) * 4 + h], l1 = LSE[((size_t)1 * MPAD + row) * 4 + h], l2 = LSE[((size_t)2 * MPAD + row) * 4 + h];
        const float mx = fmaxf(l0, fmaxf(l1, l2)); float w0 = fexp2(l0 - mx), w1 = fexp2(l1 - mx), w2 = fexp2(l2 - mx); const float inv = 1.0f / (w0 + w1 + w2); w0 *= inv; w1 *= inv; w2 *= inv;
        const size_t off = (size_t)row * 512 + h * 128 + ch * 8;
        const u32x4 a = *(const u32x4*)(AO + off), bq = *(const u32x4*)(AO + (size_t)MPAD * 512 + off), cq = *(const u32x4*)(AO + (size_t)2 * MPAD * 512 + off);
        u32x4 w;
        w.x = pk2(w0 * bflo(a.x) + w1 * bflo(bq.x) + w2 * bflo(cq.x), w0 * bfhi(a.x) + w1 * bfhi(bq.x) + w2 * bfhi(cq.x));
        w.y = pk2(w0 * bflo(a.y) + w1 * bflo(bq.y) + w2 * bflo(cq.y), w0 * bfhi(a.y) + w1 * bfhi(bq.y) + w2 * bfhi(cq.y));
        w.z = pk2(w0 * bflo(a.z) + w1 * bflo(bq.z) + w2 * bflo(cq.z), w0 * bfhi(a.z) + w1 * bfhi(bq.z) + w2 * bfhi(cq.z));
        w.w = pk2(w0 * bflo(a.w) + w1 * bflo(bq.w) + w2 * bflo(cq.w), w0 * bfhi(a.w) + w1 * bfhi(bq.w) + w2 * bfhi(cq.w));
        *(u32x4*)(br + off) = w;
    }
    __syncthreads();
}
__device__ __forceinline__ void p_final(Ctx& C) {
    const float* X = WSP(float, WS_X); const float* gf = C.a->in[26];
    for (int row = C.bid * 8 + C.wave; row < MR; row += C.G * 8) {
        f32x4 v[8]; float s = 0.f;
#pragma unroll
        for (int j = 0; j < 8; ++j) { v[j] = *(const f32x4*)(X + (size_t)row * DM + j * 256 + C.lane * 4); s += (v[j][0] * v[j][0] + v[j][1] * v[j][1]) + (v[j][2] * v[j][2] + v[j][3] * v[j][3]); }
        const float r = rsqrtf(wave_sum(s) * (1.0f / DM) + EPS);
#pragma unroll
        for (int j = 0; j < 8; ++j) { const int c = j * 256 + C.lane * 4; const f32x4 g = *(const f32x4*)(gf + c); *(f32x4*)(C.out + (size_t)row * DM + c) = v[j] * r * g; }
    }
}

__device__ __forceinline__ void ctx_init(Ctx& C, KArgs a, LAS unsigned char* lds) {
    C.lds = lds; C.tid = threadIdx.x; C.lane = C.tid & 63; C.wave = __builtin_amdgcn_readfirstlane(C.tid >> 6); C.G = gridDim.x; C.bid = blockIdx.x;
    C.a = a; C.out = a->out; C.ws = a->ws; C.ssbase = (u64*)((float*)(a->ws + WS_CTL) + CW_SS);
}
__device__ __forceinline__ f32x4 wave_gemm_global(const bf16_t* ap, const bf16_t* bp, int K) {
    f32x4 acc = (f32x4){0.f, 0.f, 0.f, 0.f};
    bf16x8 a0[8], b0[8], a1[8], b1[8];
#pragma unroll
    for (int j = 0; j < 8; ++j) { a0[j] = *(const bf16x8*)(ap + 32 * j); b0[j] = *(const bf16x8*)(bp + 32 * j); }
#pragma unroll 1
    for (int k = 0;; k += 512) {
        if (k + 256 < K) {
#pragma unroll
            for (int j = 0; j < 8; ++j) { a1[j] = *(const bf16x8*)(ap + k + 256 + 32 * j); b1[j] = *(const bf16x8*)(bp + k + 256 + 32 * j); } }
#pragma unroll
        for (int j = 0; j < 8; ++j) acc = __builtin_amdgcn_mfma_f32_16x16x32_bf16(b0[j], a0[j], acc, 0, 0, 0);
        if (k + 256 >= K) break;
        if (k + 512 < K) {
#pragma unroll
            for (int j = 0; j < 8; ++j) { a0[j] = *(const bf16x8*)(ap + k + 512 + 32 * j); b0[j] = *(const bf16x8*)(bp + k + 512 + 32 * j); } }
#pragma unroll
        for (int j = 0; j < 8; ++j) acc = __builtin_amdgcn_mfma_f32_16x16x32_bf16(b1[j], a1[j], acc, 0, 0, 0);
        if (k + 512 >= K) break;
    }
    return acc;
}
__device__ __forceinline__ void sample_res_gemm(Ctx& C, const bf16_t* A, int K, const bf16_t* Bt, u64* ssn, float alpha, int pm, int pn) {
    const int lane = C.lane, q4 = lane >> 4, cb = pn * 16 + (pm >> 1), rb = 4 * (pm & 1) + (C.wave >> 1), kh = C.wave & 1, Kh = K >> 1;
    const bf16_t* ap = A + (size_t)(MP + rb * 16 + (lane & 15)) * K + kh * Kh + q4 * 8; const bf16_t* bp = Bt + (size_t)(cb * 16 + (lane & 15)) * K + kh * Kh + q4 * 8;
    f32x4 acc = wave_gemm_global(ap, bp, Kh);
    LAS f32x4* red = (LAS f32x4*)C.lds + (C.wave >> 1) * 64 + lane;
    __syncthreads(); if (kh) *red = acc; __syncthreads();
    if (!kh) { acc += *red;
        const int row = MP + rb * 16 + (lane & 15), col = cb * 16 + 4 * q4;
        float* xp = WSP(float, WS_X) + (size_t)row * DM + col; f32x4 x = *(const f32x4*)xp; x += acc * alpha; *(f32x4*)xp = x;
        u32x2 w; w.x = pk2(x[0], x[1]); w.y = pk2(x[2], x[3]); *(u32x2*)(WSP(bf16_t, WS_XB) + (size_t)row * DM + col) = w;
        *(unsigned*)(WSP(unsigned char, WS_XB8) + (size_t)row * DM + col) = pk4_fp8(x[0] * X8_SCALE, x[1] * X8_SCALE, x[2] * X8_SCALE, x[3] * X8_SCALE);
        float s = (x[0] * x[0] + x[1] * x[1]) + (x[2] * x[2] + x[3] * x[3]); s += __shfl_xor(s, 16); s += __shfl_xor(s, 32);
        if (q4 == 0) ss_add(ssn + row, s); }
}
__device__ __forceinline__ f32x4 wave_gemm_global8(const unsigned char* ap, const unsigned char* bp, int Kb) {
    f32x4 acc = (f32x4){0.f, 0.f, 0.f, 0.f};
    bf16x8 a0[4], b0[4], a1[4], b1[4];
#pragma unroll
    for (int j = 0; j < 4; ++j) { a0[j] = *(const bf16x8*)(ap + 64 * j); b0[j] = *(const bf16x8*)(bp + 64 * j); }
#pragma unroll 1
    for (int k = 0;; k += 512) {
        if (k + 256 < Kb) {
#pragma unroll
            for (int j = 0; j < 4; ++j) { a1[j] = *(const bf16x8*)(ap + k + 256 + 64 * j); b1[j] = *(const bf16x8*)(bp + k + 256 + 64 * j); } }
        acc = pg8::mma8(b0[0], b0[1], a0[0], a0[1], acc); acc = pg8::mma8(b0[2], b0[3], a0[2], a0[3], acc);
        if (k + 256 >= Kb) break;
        if (k + 512 < Kb) {
#pragma unroll
            for (int j = 0; j < 4; ++j) { a0[j] = *(const bf16x8*)(ap + k + 512 + 64 * j); b0[j] = *(const bf16x8*)(bp + k + 512 + 64 * j); } }
        acc = pg8::mma8(b1[0], b1[1], a1[0], a1[1], acc); acc = pg8::mma8(b1[2], b1[3], a1[2], a1[3], acc);
        if (k + 512 >= Kb) break;
    }
    return acc;
}
__device__ __forceinline__ void sample_res_gemm8(Ctx& C, const unsigned char* A8, int Kb, const unsigned char* Bt8, u64* ssn, float alpha, int pm, int pn) {
    const int lane = C.lane, q4 = lane >> 4, cb = pn * 16 + (pm >> 1), rb = 4 * (pm & 1) + (C.wave >> 1), kh = C.wave & 1, Kh = Kb >> 1;
    const unsigned char* ap = A8 + (size_t)(MP + rb * 16 + (lane & 15)) * Kb + kh * Kh + q4 * 16; const unsigned char* bp = Bt8 + (size_t)(cb * 16 + (lane & 15)) * Kb + kh * Kh + q4 * 16;
    f32x4 acc = wave_gemm_global8(ap, bp, Kh);
    LAS f32x4* red = (LAS f32x4*)C.lds + (C.wave >> 1) * 64 + lane;
    __syncthreads(); if (kh) *red = acc; __syncthreads();
    if (!kh) { acc += *red;
        const int row = MP + rb * 16 + (lane & 15), col = cb * 16 + 4 * q4;
        float* xp = WSP(float, WS_X) + (size_t)row * DM + col; f32x4 x = *(const f32x4*)xp; x += acc * alpha; *(f32x4*)xp = x;
        u32x2 w; w.x = pk2(x[0], x[1]); w.y = pk2(x[2], x[3]); *(u32x2*)(WSP(bf16_t, WS_XB) + (size_t)row * DM + col) = w;
        *(unsigned*)(WSP(unsigned char, WS_XB8) + (size_t)row * DM + col) = pk4_fp8(x[0] * X8_SCALE, x[1] * X8_SCALE, x[2] * X8_SCALE, x[3] * X8_SCALE);
        float s = (x[0] * x[0] + x[1] * x[1]) + (x[2] * x[2] + x[3] * x[3]); s += __shfl_xor(s, 16); s += __shfl_xor(s, 32);
        if (q4 == 0) ss_add(ssn + row, s); }
}
__device__ __forceinline__ void sample_merge_gemm(Ctx& C, const bf16_t* WB  , int pm, int pn) {
    const int lane = C.lane, q4 = lane >> 4, cb = pn * 16 + (pm >> 1), rb = 4 * (pm & 1) + (C.wave >> 1), kh = C.wave & 1;
    const int row = MP + rb * 16 + (lane & 15), col = cb * 16 + 4 * q4; f32x4 m = (f32x4){0.f, 0.f, 0.f, 0.f};
#pragma unroll 1
    for (int n = 0; n < 4; ++n) {
        const f32x4 acc = wave_gemm_global(WSP(bf16_t, WS_BR) + ((size_t)n * MPAD + MP + rb * 16 + (lane & 15)) * 512 + kh * 256 + q4 * 8, WB + ((size_t)n * DM + cb * 16 + (lane & 15)) * 512 + kh * 256 + q4 * 8, 256);
        const u32x2 gw = *(const u32x2*)(WSP(bf16_t, WS_GATE) + (size_t)row * 8192 + n * 2048 + col);
        m[0] = (m[0] + acc[0]) * bflo(gw.x); m[1] = (m[1] + acc[1]) * bfhi(gw.x); m[2] = (m[2] + acc[2]) * bflo(gw.y); m[3] = (m[3] + acc[3]) * bfhi(gw.y);
    }
    LAS f32x4* red = (LAS f32x4*)C.lds + (C.wave >> 1) * 64 + lane;
    __syncthreads(); if (kh) *red = m; __syncthreads();
    if (!kh) { m += *red; u32x2 w; w.x = pk2(m[0], m[1]); w.y = pk2(m[2], m[3]); *(u32x2*)(WSP(bf16_t, WS_MG) + (size_t)row * DM + col) = w; }
}
struct GateOrder {
    pg8::StaticOrder P; int c;
    __device__ void init(int c_) { P.init(MPAD, INW / 2, 1, 0); c = c_; }
    __device__ bool next(int i, pg8::Unit& u) const {
        int L;
        if (i < 3) L = i * 256 + c; else if (i == 3) { if (c < 32) return false; L = 768 + (c - 32); } else if (i == 4) { if (c < 32 || c >= 96) return false; L = 992 + (c - 32); } else return false;
        pg8::StaticOrder Q = P; Q.c = L; return Q.next(0, u);
    }
    __device__ __forceinline__ void a_ready(const pg8::Unit&) const {}
    __device__ __forceinline__ void done(const pg8::Unit&) const {}
};
__device__ __forceinline__ void ph_up(Ctx& C, int l, int f) {
    unsigned char* wl = C.ws + WS_W + (size_t)l * W_LAYER;
    pg8::Gemm g{WSP(bf16_t, WS_XB), (const bf16_t*)(wl + (f ? WL_GU2 : WL_GU1)), MPAD, 2 * DFF, DM}; pg8::StaticOrder S; S.init(MPAD, 2 * DFF, C.G, C.bid);
    EpiGU E{WSP(bf16_t, WS_G), C.ssbase + (3 * l + 2 * f) * MPAD, ((D8_MASK >> (2 * l + f)) & 1) ? WSP(unsigned char, WS_G8) : nullptr};
    pg8::gemm_phase<EpiGU, pg8::StaticOrder, GP_ALIGN, GP_SP2, false, SKIP_PM>(C.lds, g, S, E);
}
__device__ __forceinline__ void ph_down(Ctx& C, int l, int f) {
    unsigned char* wl = C.ws + WS_W + (size_t)l * W_LAYER;
    pg8::Gemm g{WSP(bf16_t, WS_G), (const bf16_t*)(wl + (f ? WL_D2 : WL_D1)), MP, DM, DFF}; pg8::StaticOrder S; S.init(MP, DM, C.G, C.bid);
    const bool fin = FUSE_FINAL && l == 1 && f == 1;
    unsigned* bar = (unsigned*)(C.ws + WS_CTL) + CW_BAR; unsigned* cnt = (unsigned*)(C.ws + WS_CTL) + CW_WQ + 64;
    pg8::Unit u0; const bool has = S.next(0, u0);
    if (has) {
        if ((D8_MASK >> (2 * l + f)) & 1) sample_res_gemm8(C, C.ws + WS_G8, DFF, C.ws + WS_WD8 + (size_t)(2 * l + f) * (12u << 20), C.ssbase + (3 * l + 2 * f + 1) * MPAD, 0.5f / (X8_SCALE * W8_SCALE), u0.pm, u0.pn);
        else sample_res_gemm(C, WSP(bf16_t, WS_G), DFF, (const bf16_t*)(wl + (f ? WL_D2 : WL_D1)), C.ssbase + (3 * l + 2 * f + 1) * MPAD, 0.5f, u0.pm, u0.pn);
    }
    if (fin) { asm volatile("s_waitcnt vmcnt(0)" ::: "memory"); __syncthreads();
        if (C.tid == 0) { __builtin_amdgcn_fence(__ATOMIC_RELEASE, "agent"); asm volatile("s_waitcnt vmcnt(0)" ::: "memory"); (void)xb_add(cnt + 32, 1u); } }
    __syncthreads();
    const bool f8 = (D8_MASK >> (2 * l + f)) & 1;
    pg8::Gemm g8{(const bf16_t*)(C.ws + WS_G8), (const bf16_t*)(C.ws + WS_WD8 + (size_t)(2 * l + f) * (12u << 20)), MP, DM, DFF / 2};
    const float alpha = f8 ? 0.5f / (X8_SCALE * W8_SCALE) : 0.5f;
    if (fin) {
        EpiResFinal E{WSP(bf16_t, WS_XB), C.ssbase + (3 * l + 2 * f + 1) * MPAD, C.a->in[26], C.out, cnt, bar, alpha};
        if (f8) pg8::gemm_phase<EpiResFinal, pg8::StaticOrder, GP_ALIGN, GP_SP2, true>(C.lds, g8, S, E);
        else pg8::gemm_phase<EpiResFinal, pg8::StaticOrder, GP_ALIGN, GP_SP2>(C.lds, g, S, E);
        if (has && u0.pn == 0) {
            if (C.tid == 0) { XB_SPIN(xb_ld(cnt + 32) < (unsigned)C.G, bar); __builtin_amdgcn_fence(__ATOMIC_ACQUIRE, "agent"); asm volatile("s_waitcnt vmcnt(0)" ::: "memory"); }
            __syncthreads();
            if (C.wave < 4) { const int row = MP + u0.pm * 4 + C.wave; const float* X = WSP(float, WS_X); const float* gf = C.a->in[26];
                f32x4 v[8]; float s = 0.f;
#pragma unroll
                for (int j = 0; j < 8; ++j) { v[j] = *(const f32x4*)(X + (size_t)row * DM + j * 256 + C.lane * 4); s += (v[j][0] * v[j][0] + v[j][1] * v[j][1]) + (v[j][2] * v[j][2] + v[j][3] * v[j][3]); }
                const float r = rsqrtf(wave_sum(s) * (1.0f / DM) + EPS);
#pragma unroll
                for (int j = 0; j < 8; ++j) { const int c = j * 256 + C.lane * 4; const f32x4 gg = *(const f32x4*)(gf + c); *(f32x4*)(C.out + (size_t)row * DM + c) = v[j] * r * gg; } }
        }
    } else {
        EpiRes E{WSP(float, WS_X), WSP(bf16_t, WS_XB), C.ssbase + (3 * l + 2 * f + 1) * MPAD, f == 0 ? WSP(unsigned char, WS_XB8) : nullptr, alpha};
        if (f8) pg8::gemm_phase<EpiRes, pg8::StaticOrder, GP_ALIGN, GP_SP2, true>(C.lds, g8, S, E);
        else pg8::gemm_phase<EpiRes, pg8::StaticOrder, GP_ALIGN, GP_SP2>(C.lds, g, S, E);
    }
}
__device__ __forceinline__ void ph_win(Ctx& C, int l) {
    unsigned char* wl = C.ws + WS_W + (size_t)l * W_LAYER;
    pg8::Gemm g{WSP(bf16_t, WS_XB), (const bf16_t*)(wl + WL_IN) + (size_t)1536 * DM, MPAD, 6656, DM}; pg8::StaticOrder S; S.init(MPAD, 6656, C.G, C.bid);
    EpiIn E{C.ssbase + (3 * l + 1) * MPAD, WSP(bf16_t, WS_QKV), WSP(bf16_t, WS_BU), WSP(float, WS_BV), WSP(float, WS_CIN), WSP(bf16_t, WS_DR), WSP(bf16_t, WS_GATE),
            C.ssbase + (7 + l) * MPAD, WSP(float, WS_ROT), C.out, l, 6};
    pg8::gemm_phase<EpiIn, pg8::StaticOrder, GP_ALIGN, GP_SP2, false, SKIP_PM>(C.lds, g, S, E);
    pg8::Gemm g8{(const bf16_t*)(C.ws + WS_XB8), (const bf16_t*)(wl + WL_IN + W8_OFF), MPAD, 9728, DM / 2}; pg8::StaticOrder S8; S8.init(MPAD, 9728, C.G, C.bid);
    EpiGate E8{C.ssbase + (3 * l + 1) * MPAD, WSP(bf16_t, WS_GATE), WSP(bf16_t, WS_QKV)};
    pg8::gemm_phase<EpiGate, pg8::StaticOrder, GP_ALIGN, GP_SP2, true, SKIP_PM>(C.lds, g8, S8, E8);
}
struct MergeOrder {
    pg8::StaticOrder P;
    __device__ void init(int G, int c) { P.init(MP, DM, G, c); }
    __device__ bool next(int i, pg8::Unit& u) const { if (i >= 4 || !P.next(0, u)) return false; u.pm += (MPAD / 256) * i; u.pn += 8 * i; return true; }
    __device__ __forceinline__ void a_ready(const pg8::Unit&) const {}
    __device__ __forceinline__ void done(const pg8::Unit&) const {}
};
__device__ __forceinline__ void ph_merge(Ctx& C, int l) {
    unsigned char* wl = C.ws + WS_W + (size_t)l * W_LAYER;
    { pg8::StaticOrder S; S.init(MP, DM, C.G, C.bid); pg8::Unit u; if (S.next(0, u)) sample_merge_gemm(C, (const bf16_t*)(wl + WL_B), u.pm, u.pn); }
    __syncthreads();
    pg8::Gemm g{WSP(bf16_t, WS_BR), (const bf16_t*)(wl + WL_B), MP, DM, 512}; MergeOrder S; S.init(C.G, C.bid);
    EpiMerge E{WSP(bf16_t, WS_GATE), WSP(bf16_t, WS_MG), l};
    pg8::gemm_phase<EpiMerge, MergeOrder, GP_ALIGN, GP_SP2>(C.lds, g, S, E);
}
__device__ __forceinline__ void ph_wo(Ctx& C, int l) {
    unsigned char* wl = C.ws + WS_W + (size_t)l * W_LAYER;
    pg8::Gemm g{WSP(bf16_t, WS_MG), (const bf16_t*)(wl + WL_O), MP, DM, DM}; pg8::StaticOrder S; S.init(MP, DM, C.G, C.bid);
    EpiRes E{WSP(float, WS_X), WSP(bf16_t, WS_XB), C.ssbase + (3 * l + 2) * MPAD, nullptr, 1.0f};
    { pg8::Unit u; if (S.next(0, u)) sample_res_gemm(C, WSP(bf16_t, WS_MG), DM, (const bf16_t*)(wl + WL_O), C.ssbase + (3 * l + 2) * MPAD, 1.0f, u.pm, u.pn); }
    __syncthreads();
    pg8::gemm_phase<EpiRes, pg8::StaticOrder, GP_ALIGN, GP_SP2>(C.lds, g, S, E);
}
__global__ void __launch_bounds__(512, 2) fwd(Args args) {
    extern __shared__ __attribute__((aligned(16))) unsigned char lds_raw[];
    Ctx C; ctx_init(C, (KArgs)__builtin_amdgcn_kernarg_segment_ptr(), (LAS unsigned char*)lds_raw);
    volatile LAS unsigned* MISC = (volatile LAS unsigned*)(C.lds + MISC_OFF);
    for (int u = C.tid; u < (LDS_BYTES - RING_BYTES) / 4; u += 512) ((LAS unsigned*)(C.lds + RING_BYTES))[u] = 0u;
    __syncthreads();
#if ONE_LAUNCH
    XcdBarrier bar = xcd_barrier_post((unsigned*)(C.ws + WS_CTL) + CW_BAR, MISC + 8);
#define GRID_BAR() xcd_barrier(bar)
#else
    (void)MISC;
#define GRID_BAR() do { } while (0)
#endif
    const int lo = C.a->ph_lo, hi = C.a->ph_hi;
#define IN(k) (lo <= (k) && (k) < hi)
#define SEAM(k) do { if (IN(k) && IN((k) + 1)) GRID_BAR(); } while (0)
#define LAYER(l, pb) \
    if ((PH_MASK & 2) && IN(pb)) { ph_up(C, l, 0); SEAM(pb); } \
    if ((PH_MASK & 4) && IN(pb + 1)) { ph_down(C, l, 0); SEAM(pb + 1); } \
    if ((PH_MASK & 8) && IN(pb + 2)) { ph_win(C, l); SEAM(pb + 2); } \
    if ((PH_MASK & 16) && IN(pb + 3)) { p_mix1(C, l); if (!FUSE_MIX) SEAM(pb + 3); } \
    if ((PH_MASK & 32) && IN(pb + 4)) { p_mix2(C, l); SEAM(pb + 4); } \
    if ((PH_MASK & 64) && IN(pb + 5)) { ph_merge(C, l); SEAM(pb + 5); } \
    if ((PH_MASK & 128) && IN(pb + 6)) { ph_wo(C, l); SEAM(pb + 6); } \
    if ((PH_MASK & 2) && IN(pb + 7)) { ph_up(C, l, 1); SEAM(pb + 7); } \
    if ((PH_MASK & 4) && IN(pb + 8)) { ph_down(C, l, 1); if (!(FUSE_FINAL && (l) == 1)) SEAM(pb + 8); }
    if ((PH_MASK & 1) && IN(0)) { p_prologue(C); SEAM(0); }
    LAYER(0, 1)
    LAYER(1, 10)
    if (!FUSE_FINAL && (PH_MASK & 256) && IN(19)) p_final(C);
#undef IN
#undef SEAM
}

#ifdef ZMASK
__global__ void dbg_zero(float* dst, size_t n) { for (size_t i = (size_t)blockIdx.x * blockDim.x + threadIdx.x; i < n; i += (size_t)gridDim.x * blockDim.x) dst[i] = 0.f; }
#endif

#ifdef SELFCHK
constexpr size_t WS_REF = 1076ull << 20, WS_DIFF = 1096ull << 20;
__device__ __forceinline__ bool chk_row(int row) { return row < 2048 || row >= MP; }
__global__ void nv_gmlp(Args a, int l) {
    const unsigned char* ws = a.ws; const float* BV = (const float*)(ws + WS_BV); const bf16_t* BU = (const bf16_t*)(ws + WS_BU); const float* ssv = (const float*)(ws + WS_CTL) + CW_SS + (7 + l) * MPAD; float* REF = (float*)(ws + WS_REF);
    for (size_t i = (size_t)blockIdx.x * blockDim.x + threadIdx.x; i < (size_t)MR * 512; i += (size_t)gridDim.x * blockDim.x) {
        const int row = (int)(i >> 9), c = (int)(i & 511), g = c >> 7; if (!chk_row(row)) continue;
        const int tc = row < MP ? (row & 127) : ((row - MP) & 3), row0 = row - tc;
        float mx = a.in[16][(l * 4 + g) * 128 + tc];
        for (int s = 0; s <= tc; ++s) { const int r = row0 + s; const float vn = BV[(size_t)r * 512 + c] * rsqrtf(ssv[r] * (1.0f / 512) + EPS) * a.in[14][l * 512 + c]; mx += a.in[15][((size_t)(l * 4 + g) * 128 + tc) * 128 + s] * vn; }
        REF[(size_t)row * 512 + c] = bf2f(BU[(size_t)row * 512 + c]) * mx;
    }
}
__global__ void nv_pool_diff(Args a, int l) {
    const unsigned char* ws = a.ws; const float* CIN = (const float*)(ws + WS_CIN); float* DIFF = (float*)(ws + WS_DIFF);
    for (size_t i = (size_t)blockIdx.x * blockDim.x + threadIdx.x; i < (size_t)MR * 512; i += (size_t)gridDim.x * blockDim.x) {
        const int row = (int)(i >> 9), col = (int)(i & 511), g = col >> 7, win = 2 << g; if (!chk_row(row)) continue;
        float wsum = 0.f, cnt;
        if (row < MP) { const int t = row & 2047; for (int k = 0; k < win; ++k) if (t - k >= 0) wsum += CIN[(size_t)(row - k) * 512 + col]; cnt = (float)((t + 1) < win ? (t + 1) : win); }
        else { const int rs = row - MP, b = rs >> 2, s = rs & 3; for (int k = 0; k < win; ++k) { const int idx = 15 + s - k; wsum += idx < 15 ? a.in[5][((size_t)(l * 32 + b) * 15 + idx) * 512 + col] : CIN[(size_t)(MP + b * 4 + idx - 15) * 512 + col]; } cnt = (float)win; }
        DIFF[(size_t)row * 512 + col] = wsum / cnt - CIN[(size_t)row * 512 + col];
    }
}
__global__ void nv_pool_mm(Args a, int l) {
    const unsigned char* ws = a.ws; const float* DIFF = (const float*)(ws + WS_DIFF); float* REF = (float*)(ws + WS_REF);
    for (size_t i = (size_t)blockIdx.x * blockDim.x + threadIdx.x; i < (size_t)MR * 512; i += (size_t)gridDim.x * blockDim.x) {
        const int row = (int)(i >> 9), dd = (int)(i & 511), g = dd >> 7, d = dd & 127; if (!chk_row(row)) continue;
        float y = 0.f; for (int c = 0; c < 128; ++c) y += DIFF[(size_t)row * 512 + g * 128 + c] * a.in[17][((size_t)(l * 4 + g) * 128 + c) * 128 + d];
        REF[(size_t)row * 512 + dd] = y * a.in[18][l * 512 + dd];
    }
}
__global__ void nv_ret(Args a, int l) {
    __shared__ float dots[128]; __shared__ float red[128]; __shared__ float qsh[128];
    const unsigned char* ws = a.ws; const bf16_t* DR = (const bf16_t*)(ws + WS_DR); float* REF = (float*)(ws + WS_REF);
    const int e = threadIdx.x;
    for (int item = blockIdx.x; item < (2048 + 128) * 4; item += gridDim.x) {
        const int h = item & 3, rr = item >> 2, row = rr < 2048 ? rr : MP + (rr - 2048);
        const float lg = lg2gamma(h); float o = 0.f;
        __syncthreads(); qsh[e] = bf2f(DR[(size_t)row * 2048 + h * 128 + e]); __syncthreads();
        if (row < MP) { const int t = row;
            for (int s0 = 0; s0 <= t; s0 += 128) {
                const int s = s0 + e; float d = 0.f;
                if (s <= t) { for (int k = 0; k < 128; ++k) d += qsh[k] * bf2f(DR[(size_t)s * 2048 + 512 + h * 128 + k]); d *= exp2f((float)(t - s) * lg); }
                __syncthreads(); dots[e] = d; __syncthreads();
                const int ns = (t - s0 + 1) < 128 ? (t - s0 + 1) : 128;
                for (int i = 0; i < ns; ++i) o += dots[i] * bf2f(DR[(size_t)(s0 + i) * 2048 + 1024 + h * 128 + e]);
            }
        } else { const int rs = row - MP, b = rs >> 2, t = rs & 3; const float* S0 = a.in[6] + ((size_t)(l * 32 + b) * 4 + h) * 16384;
            float st = 0.f; for (int d = 0; d < 128; ++d) st += qsh[d] * S0[d * 128 + e]; o = st * exp2f((float)(t + 1) * lg);
            for (int s = 0; s <= t; ++s) { float d = 0.f; for (int k = 0; k < 128; ++k) d += qsh[k] * bf2f(DR[(size_t)(MP + b * 4 + s) * 2048 + 512 + h * 128 + k]); o += exp2f((float)(t - s) * lg) * d * bf2f(DR[(size_t)(MP + b * 4 + s) * 2048 + 1024 + h * 128 + e]); }
        }
        __syncthreads(); red[e] = o * o; __syncthreads();
        for (int w = 64; w >= 1; w >>= 1) { if (e < w) red[e] += red[e + w]; __syncthreads(); }
        const float rn = rsqrtf(red[0] * (1.0f / 128) + EPS);
        REF[(size_t)row * 512 + h * 128 + e] = o * rn * a.in[19][l * 512 + h * 128 + e] * bf2f(DR[(size_t)row * 2048 + 1536 + h * 128 + e]);
    }
}
__global__ void nv_merge(Args a, int l) {
    const unsigned char* ws = a.ws; const bf16_t* BR = (const bf16_t*)(ws + WS_BR); const bf16_t* GATE = (const bf16_t*)(ws + WS_GATE); float* REF = (float*)(ws + WS_REF);
    for (size_t i = (size_t)blockIdx.x * blockDim.x + threadIdx.x; i < (size_t)MR * 2048; i += (size_t)gridDim.x * blockDim.x) {
        const int row = (int)(i >> 11), d = (int)(i & 2047); if (!chk_row(row)) continue;
        float m = 0.f;
        for (int n = 0; n < 4; ++n) { float acc = 0.f; const bf16_t* br = BR + ((size_t)n * MPAD + row) * 512; const float* w = a.in[20] + ((size_t)(l * 4 + n) * 512) * 2048 + d;
            for (int c = 0; c < 512; ++c) acc += bf2f(br[c]) * w[(size_t)c * 2048];
            m += bf2f(GATE[(size_t)row * 8192 + n * 2048 + d]) * acc; }
        REF[(size_t)row * 2048 + d] = m;
    }
}
__global__ void nv_cmp(const bf16_t* fast, const float* ref, int ncol, float* acc  ) {
    float np = 0.f, dp = 0.f, ns = 0.f, ds = 0.f;
    for (size_t i = (size_t)blockIdx.x * blockDim.x + threadIdx.x; i < (size_t)MR * ncol; i += (size_t)gridDim.x * blockDim.x) {
        const int row = (int)(i / ncol); if (!chk_row(row)) continue;
        const float f = bf2f(fast[i]), r = ref[i], df = f - r;
        if (row < MP) { np += df * df; dp += r * r; } else { ns += df * df; ds += r * r; }
    }
    np = wave_sum(np); dp = wave_sum(dp); ns = wave_sum(ns); ds = wave_sum(ds);
    if ((threadIdx.x & 63) == 0) { atomicAdd(acc + 0, np); atomicAdd(acc + 1, dp); atomicAdd(acc + 2, ns); atomicAdd(acc + 3, ds); }
}
__global__ void nv_report(const float* acc, float* ysample, int which  ) {
    const float rel = acc[2 * which] / fmaxf(acc[2 * which + 1], 1e-30f); const float c = 100.0f * sqrtf(sqrtf(fmaxf(rel, 1e-12f)));
    for (size_t i = (size_t)blockIdx.x * blockDim.x + threadIdx.x; i < (size_t)MS * DM; i += (size_t)gridDim.x * blockDim.x) ysample[i] = c;
}
#endif
#ifdef KEEP_EXPR
__global__ void dbg_keep(float* y) { for (size_t i = (size_t)blockIdx.x * blockDim.x + threadIdx.x; i < (size_t)MP * DM; i += (size_t)gridDim.x * blockDim.x) { const int row = (int)(i >> 11), col = (int)(i & 2047); (void)row; (void)col; if (!(KEEP_EXPR)) y[i] = 0.f; } }
#endif
#ifdef DBG_LAST
__global__ void dbg_dump(const float* src, float* dst, size_t n) { for (size_t i = (size_t)blockIdx.x * blockDim.x + threadIdx.x; i < n; i += (size_t)gridDim.x * blockDim.x) dst[i] = src[i]; }
#endif
extern "C" void kernel_launch(void* const* d_in, const int* in_sizes, int n_in, void* d_out, int out_size, void* d_ws, size_t ws_size, hipStream_t stream) {
    static int grid = 0;
    if (grid == 0) {
        if (n_in != 27 || out_size != (int)O_END || ws_size < WS_END) { fprintf(stderr, "kernel_launch: unexpected problem: n_in %d out %d ws %zu\n", n_in, out_size, ws_size); grid = -1; return; }
        int dev = 0, cus = 0, per_cu = 0;
        if (hipGetDevice(&dev) != hipSuccess || hipDeviceGetAttribute(&cus, hipDeviceAttributeMultiprocessorCount, dev) != hipSuccess) { grid = -1; return; }
        if (hipFuncSetAttribute((const void*)fwd, hipFuncAttributeMaxDynamicSharedMemorySize, LDS_BYTES) != hipSuccess) { fprintf(stderr, "kernel_launch: hipFuncSetAttribute failed\n"); grid = -1; return; }
        if (hipOccupancyMaxActiveBlocksPerMultiprocessor(&per_cu, (const void*)fwd, 512, LDS_BYTES) != hipSuccess || per_cu < 1) { fprintf(stderr, "kernel_launch: occupancy query says %d\n", per_cu); }
        (void)hipGetLastError();
        grid = cus;
    }
    if (grid < 0) return;
    (void)hipMemsetAsync((char*)d_ws + WS_CTL, 0, CTL_ZERO_BYTES, stream);
    Args a{};
    for (int i = 0; i < 27; ++i) a.in[i] = (const float*)d_in[i];
    a.out = (float*)d_out; a.ws = (unsigned char*)d_ws;
#if ONE_LAUNCH
    a.ph_lo = 0; a.ph_hi = NPHASE;
    hipLaunchKernelGGL(fwd, dim3(grid), dim3(512), LDS_BYTES, stream, a);
#else
#ifdef DBG_LAST
    for (int p = 0; p <= DBG_LAST; ++p) { a.ph_lo = p; a.ph_hi = p + 1; hipLaunchKernelGGL(fwd, dim3(grid), dim3(512), LDS_BYTES, stream, a); }
    hipLaunchKernelGGL(dbg_dump, dim3(2048), dim3(256), 0, stream, (const float*)((char*)d_ws + DBG_OFF), (float*)d_out, (size_t)DBG_N);
#else
    for (int p = 0; p < NPHASE; ++p) {
#ifdef SKIP_MASK
        if ((SKIP_MASK >> p) & 1) continue;
#endif
        a.ph_lo = p; a.ph_hi = p + 1; hipLaunchKernelGGL(fwd, dim3(grid), dim3(512), LDS_BYTES, stream, a);
#ifdef SELFCHK
        { const int L = SELFCHK_LAYER; float* acc = (float*)((char*)d_ws + WS_CTL) + 1024; unsigned char* w8 = (unsigned char*)d_ws;
          if (p == 1 + 9 * L + 4 && SELFCHK >= 1 && SELFCHK <= 3) {
              if (SELFCHK == 1) hipLaunchKernelGGL(nv_gmlp, dim3(2048), dim3(256), 0, stream, a, L);
              if (SELFCHK == 2) { hipLaunchKernelGGL(nv_pool_diff, dim3(2048), dim3(256), 0, stream, a, L); hipLaunchKernelGGL(nv_pool_mm, dim3(2048), dim3(256), 0, stream, a, L); }
              if (SELFCHK == 3) hipLaunchKernelGGL(nv_ret, dim3(2176), dim3(128), 0, stream, a, L);
              hipLaunchKernelGGL(nv_cmp, dim3(1024), dim3(256), 0, stream, (const bf16_t*)(w8 + WS_BR) + (size_t)SELFCHK * MPAD * 512, (const float*)(w8 + WS_REF), 512, acc); }
          if (p == 1 + 9 * L + 5 && SELFCHK == 4) {
              hipLaunchKernelGGL(nv_merge, dim3(4096), dim3(256), 0, stream, a, L);
              hipLaunchKernelGGL(nv_cmp, dim3(1024), dim3(256), 0, stream, (const bf16_t*)(w8 + WS_MG), (const float*)(w8 + WS_REF), 2048, acc); } }
#endif
    }
#ifdef SELFCHK
    hipLaunchKernelGGL(nv_report, dim3(256), dim3(256), 0, stream, (const float*)((char*)d_ws + WS_CTL) + 1024, (float*)d_out + (size_t)MP * DM, SELFCHK_WHICH);
#endif
#endif
#endif
#ifdef KEEP_EXPR
    hipLaunchKernelGGL(dbg_keep, dim3(2048), dim3(256), 0, stream, (float*)d_out);
#endif
#ifdef ZMASK
    { const size_t offs[14] = {0, (size_t)MP * DM, O_KVP0, O_KVP1, O_KVP2, O_KVS0, O_KVS1, O_KVS2, O_POOLP, O_POOLS, O_RETP, O_RETS, O_GVS, O_END};
      for (int k = 0; k < 13; ++k) if ((ZMASK >> k) & 1) hipLaunchKernelGGL(dbg_zero, dim3(256), dim3(256), 0, stream, (float*)d_out + offs[k], (offs[k + 1] - offs[k]) / 10); }
#endif
}
```
